# Optimizing an MI355X kernel written in HIP

```python
import math
import jax
import jax.numpy as jnp
from jax import lax
import numpy as np

D_MODEL = 1024
BATCH = 8
SEQ = 2048
DEPTH = 4

CTX_LEN = 256
GRID_W = 64
HEAD_DIM = 64
NA_HEADS = 4
NA_ROWS_MAX = 8
NA_COLS = 16
GA_HEADS = 4
GA_KV_HEADS = 2
SSM_GROUPS = 16
SSM_GROUP_CH = 16
SSM_STATE = 64
SW_HEADS = 4
SW_KV_HEADS = 2
SW_WINDOW = 128
Q_BLOCK = 128
NA_WIDTH = NA_HEADS * HEAD_DIM
GA_WIDTH = GA_HEADS * HEAD_DIM
GA_KV_WIDTH = GA_KV_HEADS * HEAD_DIM
SSM_WIDTH = SSM_GROUPS * SSM_GROUP_CH
SW_WIDTH = SW_HEADS * HEAD_DIM
SW_KV_WIDTH = SW_KV_HEADS * HEAD_DIM
MIX_WIDTH = NA_WIDTH + GA_WIDTH + SSM_WIDTH + SW_WIDTH
IN_SIZES = (NA_WIDTH, NA_WIDTH, NA_WIDTH, GA_WIDTH, GA_KV_WIDTH, GA_KV_WIDTH, SSM_WIDTH, SW_WIDTH, SW_KV_WIDTH, SW_KV_WIDTH)
IN_WIDTH = sum(IN_SIZES)
D_FF = 2816
N_EXPERTS = 8
TOP_K = 2
D_FF_EXPERT = 3584
ADA_CHUNKS = 6
ROPE_THETA = 10000.0
LN_EPS = 1e-6
RMS_EPS = 1e-6
NEG_INF = -1e30
DEEPNORM_ALPHA = (2 * DEPTH) ** 0.25
DEEPNORM_BETA = (8 * DEPTH) ** -0.25
F32 = jnp.float32

kernel_name = 'hybrid_dit_parallel_mixer_trunk'


def _layer_norm(x, g, b):
    xf = x.astype(F32)
    xc = xf - jnp.mean(xf, -1, keepdims=True)
    y = xc * lax.rsqrt(jnp.mean(xc * xc, -1, keepdims=True) + LN_EPS)
    return (y * g.astype(F32) + b.astype(F32)).astype(x.dtype)


def _rms_norm(x, g):
    xf = x.astype(F32)
    y = xf * lax.rsqrt(jnp.mean(xf * xf, -1, keepdims=True) + RMS_EPS)
    return (y * g.astype(F32)).astype(x.dtype)


def _heads(t):
    return t.reshape(t.shape[:-1] + (t.shape[-1] // HEAD_DIM, HEAD_DIM))


def _split_cols(p):
    return jnp.split(p, np.cumsum(IN_SIZES)[:-1].tolist(), axis=-1)


def _axial_rope_tables(n_tokens):
    pos = jnp.arange(n_tokens, dtype=jnp.int32)
    row = (pos // GRID_W).astype(F32)
    col = (pos % GRID_W).astype(F32)
    n_freq = HEAD_DIM // 4
    inv_freq = ROPE_THETA ** (-jnp.arange(n_freq, dtype=F32) / n_freq)
    ang = jnp.concatenate([row[:, None] * inv_freq, col[:, None] * inv_freq], axis=-1)
    return jnp.cos(ang), jnp.sin(ang)


def _apply_rope(x, cos, sin):
    xf = x.astype(F32)
    x1, x2 = jnp.split(xf, 2, axis=-1)
    c = cos[None, :, None, :]
    s = sin[None, :, None, :]
    return jnp.concatenate([x1 * c - x2 * s, x1 * s + x2 * c], axis=-1).astype(x.dtype)


def _sink_softmax(s, sink_b):
    m = jnp.maximum(jnp.max(s, -1, keepdims=True), sink_b)
    e = jnp.exp(s - m)
    return e / (jnp.sum(e, -1, keepdims=True) + jnp.exp(sink_b - m))


def _context_attention(q, k, v, sink=None):
    b, n, hq, dh = q.shape
    g = k.shape[2]
    r = hq // g
    qg = q.reshape(b, n, g, r, dh)
    s = jnp.einsum('bqgrd,bkgd->bgrqk', qg, k, preferred_element_type=F32) * (dh ** -0.5)
    if sink is None:
        p = jax.nn.softmax(s, -1)
    else:
        p = _sink_softmax(s, sink.astype(F32).reshape(1, g, r, 1, 1))
    o = jnp.einsum('bgrqk,bkgd->bqgrd', p.astype(v.dtype), v)
    return o.reshape(b, n, hq * dh)


def _neighbourhood_attention(q, k, v, k_ctx, v_ctx, rpb):
    b, n, h, dh = q.shape
    rows = n // GRID_W
    kh = min(NA_ROWS_MAX, rows)
    r_idx = jnp.arange(rows)
    row_start = jnp.clip(r_idx - kh // 2, 0, rows - kh)
    band_rows = row_start[:, None] + jnp.arange(kh)[None, :]
    qg = q.reshape(b, rows, GRID_W, h, dh)
    kg = k.reshape(b, rows, GRID_W, h, dh)[:, band_rows]
    vg = v.reshape(b, rows, GRID_W, h, dh)[:, band_rows]
    c_idx = jnp.arange(GRID_W)
    col_start = jnp.clip(c_idx - NA_COLS // 2, 0, GRID_W - NA_COLS)
    col_valid = (c_idx[None, :] >= col_start[:, None]) & (c_idx[None, :] < col_start[:, None] + NA_COLS)
    row_rel = band_rows - r_idx[:, None] + NA_ROWS_MAX - 1
    col_rel = jnp.clip(c_idx[None, :] - c_idx[:, None], 1 - NA_COLS, NA_COLS - 1) + NA_COLS - 1
    bias = rpb.astype(F32)[:, row_rel[:, None, :, None], col_rel[None, :, None, :]]
    scale = dh ** -0.5
    s_loc = jnp.einsum('brqhd,brikhd->bhrqik', qg, kg, preferred_element_type=F32) * scale + bias
    s_loc = jnp.where(col_valid[:, None, :], s_loc, NEG_INF).reshape(b, h, rows, GRID_W, kh * GRID_W)
    s_ctx = jnp.einsum('brqhd,bchd->bhrqc', qg, k_ctx, preferred_element_type=F32) * scale
    p = jax.nn.softmax(jnp.concatenate([s_loc, s_ctx], -1), -1).astype(v.dtype)
    n_loc = kh * GRID_W
    p_loc = p[..., :n_loc].reshape(b, h, rows, GRID_W, kh, GRID_W)
    o = (jnp.einsum('bhrqik,brikhd->brqhd', p_loc, vg)
         + jnp.einsum('bhrqc,bchd->brqhd', p[..., n_loc:], v_ctx))
    return o.reshape(b, n, h * dh)


def _global_gqa(q, k, v, k_ctx, v_ctx):
    b, n, hq, dh = q.shape
    g = k.shape[2]
    r = hq // g
    k_all = jnp.concatenate([k_ctx, k], axis=1)
    v_all = jnp.concatenate([v_ctx, v], axis=1)
    qb = jnp.moveaxis(q.reshape(b, n // Q_BLOCK, Q_BLOCK, g, r, dh), 1, 0)

    def attend(qi):
        s = jnp.einsum('bqgrd,bkgd->bgrqk', qi, k_all, preferred_element_type=F32) * (dh ** -0.5)
        p = jax.nn.softmax(s, -1).astype(v_all.dtype)
        return jnp.einsum('bgrqk,bkgd->bqgrd', p, v_all)

    o = lax.map(attend, qb)
    return jnp.moveaxis(o, 0, 1).reshape(b, n, hq * dh)


def _window_gqa(q, k, v, k_ctx, v_ctx, sink):
    b, n, hq, dh = q.shape
    g = k.shape[2]
    r = hq // g
    nb = n // Q_BLOCK
    side = SW_WINDOW // Q_BLOCK
    span = (2 * side + 1) * Q_BLOCK

    def band(t):
        tp = jnp.pad(t, ((0, 0), (SW_WINDOW, SW_WINDOW), (0, 0), (0, 0))).reshape(b, nb + 2 * side, Q_BLOCK, g, dh)
        return jnp.concatenate([tp[:, j:j + nb] for j in range(2 * side + 1)], axis=2)

    kw = band(k)
    vw = band(v)
    blk = jnp.arange(nb)[:, None, None] * Q_BLOCK
    qpos = blk + jnp.arange(Q_BLOCK)[None, :, None]
    kpos = blk - SW_WINDOW + jnp.arange(span)[None, None, :]
    valid = (kpos >= 0) & (kpos < n) & (jnp.abs(kpos - qpos) <= SW_WINDOW)
    qg = q.reshape(b, nb, Q_BLOCK, g, r, dh)
    scale = dh ** -0.5
    s_loc = jnp.einsum('bnqgrd,bnkgd->bgrnqk', qg, kw, preferred_element_type=F32) * scale
    s_loc = jnp.where(valid, s_loc, NEG_INF)
    s_ctx = jnp.einsum('bnqgrd,bcgd->bgrnqc', qg, k_ctx, preferred_element_type=F32) * scale
    p = _sink_softmax(jnp.concatenate([s_loc, s_ctx], -1), sink.astype(F32).reshape(1, g, r, 1, 1, 1)).astype(v.dtype)
    o = (jnp.einsum('bgrnqk,bnkgd->bnqgrd', p[..., :span], vw)
         + jnp.einsum('bgrnqc,bcgd->bnqgrd', p[..., span:], v_ctx))
    return o.reshape(b, n, hq * dh)


def _s5_discretise(lam_re, lam_im, log_step, b_re, b_im):
    lam_re = lam_re.astype(F32)
    lam_im = lam_im.astype(F32)
    step = jnp.exp(log_step.astype(F32))[:, None]
    mag = jnp.exp(lam_re * step)
    ab_re = mag * jnp.cos(lam_im * step)
    ab_im = mag * jnp.sin(lam_im * step)
    den = lam_re * lam_re + lam_im * lam_im
    num_re = ab_re - 1.0
    f_re = ((num_re * lam_re + ab_im * lam_im) / den)[..., None]
    f_im = ((ab_im * lam_re - num_re * lam_im) / den)[..., None]
    b_re = b_re.astype(F32)
    b_im = b_im.astype(F32)
    return ab_re, ab_im, f_re * b_re - f_im * b_im, f_re * b_im + f_im * b_re


def _complex_linear_scan(u, ab_re, ab_im, bb_re, bb_im, reverse):
    bu_re = jnp.einsum('blgh,gph->blgp', u, bb_re)
    bu_im = jnp.einsum('blgh,gph->blgp', u, bb_im)
    a_re = jnp.broadcast_to(ab_re, bu_re.shape)
    a_im = jnp.broadcast_to(ab_im, bu_re.shape)

    def combine(e1, e2):
        a1r, a1i, b1r, b1i = e1
        a2r, a2i, b2r, b2i = e2
        return (a2r * a1r - a2i * a1i, a2r * a1i + a2i * a1r,
                a2r * b1r - a2i * b1i + b2r, a2r * b1i + a2i * b1r + b2i)

    return lax.associative_scan(combine, (a_re, a_im, bu_re, bu_im), axis=1, reverse=reverse)


def _s5_readout(h_re, h_im, c_re, c_im):
    return (jnp.einsum('blgp,ghp->blgh', h_re, c_re.astype(F32))
            - jnp.einsum('blgp,ghp->blgh', h_im, c_im.astype(F32)))


def _s5_mixer(u_lat, u_ctx, lam_re, lam_im, log_step, b_re, b_im, c_re, c_im, d_skip, w_glu, need_ctx):
    b, n, _ = u_lat.shape
    nc = u_ctx.shape[1]
    ul = u_lat.astype(F32).reshape(b, n, SSM_GROUPS, SSM_GROUP_CH)
    uc = u_ctx.astype(F32).reshape(b, nc, SSM_GROUPS, SSM_GROUP_CH)
    d = d_skip.astype(F32).reshape(SSM_GROUPS, SSM_GROUP_CH)
    y_lat = d * ul
    y_ctx = d * uc if need_ctx else None
    for direction in range(2):
        reverse = direction == 1
        ab_re, ab_im, bb_re, bb_im = _s5_discretise(lam_re[direction], lam_im[direction], log_step[direction],
                                                    b_re[direction], b_im[direction])
        _, _, hc_re, hc_im = _complex_linear_scan(uc, ab_re, ab_im, bb_re, bb_im, reverse)
        end = 0 if reverse else nc - 1
        h0_re = hc_re[:, end][:, None]
        h0_im = hc_im[:, end][:, None]
        ac_re, ac_im, hl_re, hl_im = _complex_linear_scan(ul, ab_re, ab_im, bb_re, bb_im, reverse)
        hl_re, hl_im = (hl_re + ac_re * h0_re - ac_im * h0_im,
                        hl_im + ac_re * h0_im + ac_im * h0_re)
        y_lat = y_lat + _s5_readout(hl_re, hl_im, c_re[direction], c_im[direction])
        if need_ctx:
            y_ctx = y_ctx + _s5_readout(hc_re, hc_im, c_re[direction], c_im[direction])

    def glu(y, m):
        y = jax.nn.gelu(y.reshape(b, m, SSM_WIDTH))
        return (y * jax.nn.sigmoid(y @ w_glu.astype(F32))).astype(u_lat.dtype)

    return glu(y_lat, n), (glu(y_ctx, nc) if need_ctx else None)


def _parallel_mixer(a_lat, a_ctx, cos, sin, w_in, w_out, na_rpb, ga_q_norm, ga_k_norm,
                    lam_re, lam_im, log_step, b_re, b_im, c_re, c_im, d_skip, w_glu, sw_sink, need_ctx):
    qa, ka, va, qb, kb, vb, u, qd, kd, vd = _split_cols(a_lat @ w_in)
    qa_c, ka_c, va_c, qb_c, kb_c, vb_c, u_c, qd_c, kd_c, vd_c = _split_cols(a_ctx @ w_in)
    ka_c, va_c = _heads(ka_c), _heads(va_c)
    out_a = _neighbourhood_attention(_heads(qa), _heads(ka), _heads(va), ka_c, va_c, na_rpb)
    kb_c, vb_c = _rms_norm(_heads(kb_c), ga_k_norm), _heads(vb_c)
    qb = _apply_rope(_rms_norm(_heads(qb), ga_q_norm), cos, sin)
    kb = _apply_rope(_rms_norm(_heads(kb), ga_k_norm), cos, sin)
    out_b = _global_gqa(qb, kb, _heads(vb), kb_c, vb_c)
    out_c, ctx_c = _s5_mixer(u, u_c, lam_re, lam_im, log_step, b_re, b_im, c_re, c_im, d_skip, w_glu, need_ctx)
    kd_c, vd_c = _heads(kd_c), _heads(vd_c)
    qd = _apply_rope(_heads(qd), cos, sin)
    kd = _apply_rope(_heads(kd), cos, sin)
    out_d = _window_gqa(qd, kd, _heads(vd), kd_c, vd_c, sw_sink)
    y_lat = jnp.concatenate([out_a, out_b, out_c, out_d], axis=-1) @ w_out
    if not need_ctx:
        return y_lat, None
    ctx_a = _context_attention(_heads(qa_c), ka_c, va_c)
    ctx_b = _context_attention(_rms_norm(_heads(qb_c), ga_q_norm), kb_c, vb_c)
    ctx_d = _context_attention(_heads(qd_c), kd_c, vd_c, sw_sink)
    y_ctx = jnp.concatenate([ctx_a, ctx_b, ctx_c, ctx_d], axis=-1) @ w_out
    return y_lat, y_ctx


def _swiglu(h, w_gate, w_up, w_down):
    return (jax.nn.silu(h @ w_gate) * (h @ w_up)) @ w_down


def _moe_swiglu(h, w_router, b_router, w_gate, w_up, w_down):
    logits = jnp.einsum('bld,de->ble', h, w_router, preferred_element_type=F32) + b_router.astype(F32)
    top_val, top_idx = lax.top_k(logits, TOP_K)
    top_w = jax.nn.softmax(top_val, -1)
    gate = jnp.sum(jax.nn.one_hot(top_idx, N_EXPERTS, dtype=F32) * top_w[..., None], axis=-2)
    out = jnp.zeros(h.shape, F32)
    for e in range(N_EXPERTS):
        out = out + gate[..., e:e + 1] * _swiglu(h, w_gate[e], w_up[e], w_down[e]).astype(F32)
    return out.astype(h.dtype)


def setup_inputs(seed: int = 0) -> dict:
    key = jax.random.key(seed)
    k = jax.random.split(key, 33)
    n_dense = (DEPTH + 1) // 2
    n_moe = DEPTH // 2

    def nrm(kk, shape, std):
        return std * jax.random.normal(kk, shape, F32)

    lam_im_base = jnp.pi * jnp.arange(SSM_STATE, dtype=F32)
    return {
        'x': nrm(k[0], (BATCH, SEQ, D_MODEL), 1.0),
        'c': nrm(k[1], (BATCH, D_MODEL), 1.0),
        'ctx': nrm(k[2], (BATCH, CTX_LEN, D_MODEL), 1.0),
        'c_ctx': nrm(k[3], (D_MODEL,), 1.0),
        'ada_w': nrm(k[4], (DEPTH, D_MODEL, ADA_CHUNKS * D_MODEL), 0.5 * D_MODEL ** -0.5),
        'ada_b': nrm(k[5], (DEPTH, ADA_CHUNKS * D_MODEL), 0.02),
        'w_in': nrm(k[6], (DEPTH, D_MODEL, IN_WIDTH), D_MODEL ** -0.5),
        'w_out': nrm(k[7], (DEPTH, MIX_WIDTH, D_MODEL), DEEPNORM_BETA * MIX_WIDTH ** -0.5),
        'na_rpb': nrm(k[8], (DEPTH, NA_HEADS, 2 * NA_ROWS_MAX - 1, 2 * NA_COLS - 1), 0.02),
        'ga_q_norm': 1.0 + nrm(k[9], (DEPTH, HEAD_DIM), 0.02),
        'ga_k_norm': 1.0 + nrm(k[10], (DEPTH, HEAD_DIM), 0.02),
        'ssm_lambda_re': -0.5 + nrm(k[11], (DEPTH, 2, SSM_GROUPS, SSM_STATE), 0.01),
        'ssm_lambda_im': lam_im_base + nrm(k[12], (DEPTH, 2, SSM_GROUPS, SSM_STATE), 0.01),
        'ssm_log_step': jax.random.uniform(k[13], (DEPTH, 2, SSM_GROUPS), F32, math.log(1e-3), math.log(1e-1)),
        'ssm_b_re': nrm(k[14], (DEPTH, 2, SSM_GROUPS, SSM_STATE, SSM_GROUP_CH), (2 * SSM_GROUP_CH) ** -0.5),
        'ssm_b_im': nrm(k[15], (DEPTH, 2, SSM_GROUPS, SSM_STATE, SSM_GROUP_CH), (2 * SSM_GROUP_CH) ** -0.5),
        'ssm_c_re': nrm(k[16], (DEPTH, 2, SSM_GROUPS, SSM_GROUP_CH, SSM_STATE), SSM_STATE ** -0.5),
        'ssm_c_im': nrm(k[17], (DEPTH, 2, SSM_GROUPS, SSM_GROUP_CH, SSM_STATE), SSM_STATE ** -0.5),
        'ssm_d': nrm(k[18], (DEPTH, SSM_WIDTH), 1.0),
        'ssm_w_glu': nrm(k[19], (DEPTH, SSM_WIDTH, SSM_WIDTH), SSM_WIDTH ** -0.5),
        'sw_sink': nrm(k[20], (DEPTH, SW_HEADS), 0.5),
        'ln1_g': 1.0 + nrm(k[21], (DEPTH, D_MODEL), 0.02),
        'ln1_b': nrm(k[22], (DEPTH, D_MODEL), 0.02),
        'ln2_g': 1.0 + nrm(k[23], (DEPTH, D_MODEL), 0.02),
        'ln2_b': nrm(k[24], (DEPTH, D_MODEL), 0.02),
        'ffn_w_gate': nrm(k[25], (n_dense, D_MODEL, D_FF), D_MODEL ** -0.5),
        'ffn_w_up': nrm(k[26], (n_dense, D_MODEL, D_FF), D_MODEL ** -0.5),
        'ffn_w_down': nrm(k[27], (n_dense, D_FF, D_MODEL), DEEPNORM_BETA * D_FF ** -0.5),
        'moe_w_router': nrm(k[28], (n_moe, D_MODEL, N_EXPERTS), D_MODEL ** -0.5),
        'moe_b_router': nrm(k[29], (n_moe, N_EXPERTS), 0.01),
        'moe_w_gate': nrm(k[30], (n_moe, N_EXPERTS, D_MODEL, D_FF_EXPERT), D_MODEL ** -0.5),
        'moe_w_up': nrm(k[31], (n_moe, N_EXPERTS, D_MODEL, D_FF_EXPERT), D_MODEL ** -0.5),
        'moe_w_down': nrm(k[32], (n_moe, N_EXPERTS, D_FF_EXPERT, D_MODEL), DEEPNORM_BETA * D_FF_EXPERT ** -0.5),
    }


def reference(x, c, ctx, c_ctx, ada_w, ada_b, w_in, w_out, na_rpb, ga_q_norm, ga_k_norm,
              ssm_lambda_re, ssm_lambda_im, ssm_log_step, ssm_b_re, ssm_b_im, ssm_c_re, ssm_c_im,
              ssm_d, ssm_w_glu, sw_sink, ln1_g, ln1_b, ln2_g, ln2_b,
              ffn_w_gate, ffn_w_up, ffn_w_down,
              moe_w_router, moe_b_router, moe_w_gate, moe_w_up, moe_w_down):
    n = x.shape[1]
    cos, sin = _axial_rope_tables(n)
    act_c = jax.nn.silu(c)
    act_cc = jax.nn.silu(c_ctx)
    h, hc = x, ctx
    for layer in range(DEPTH):
        need_ctx = layer < DEPTH - 1
        shift1, scale1, gate1, shift2, scale2, gate2 = [
            m[:, None, :] for m in jnp.split(act_c @ ada_w[layer] + ada_b[layer], ADA_CHUNKS, axis=-1)]
        shift1c, scale1c, gate1c, shift2c, scale2c, gate2c = jnp.split(
            act_cc @ ada_w[layer] + ada_b[layer], ADA_CHUNKS, axis=-1)
        y, yc = _parallel_mixer(
            h * (1.0 + scale1) + shift1, hc * (1.0 + scale1c) + shift1c, cos, sin,
            w_in[layer], w_out[layer], na_rpb[layer], ga_q_norm[layer], ga_k_norm[layer],
            ssm_lambda_re[layer], ssm_lambda_im[layer], ssm_log_step[layer],
            ssm_b_re[layer], ssm_b_im[layer], ssm_c_re[layer], ssm_c_im[layer],
            ssm_d[layer], ssm_w_glu[layer], sw_sink[layer], need_ctx)
        h = _layer_norm(DEEPNORM_ALPHA * h + gate1 * y, ln1_g[layer], ln1_b[layer])
        if need_ctx:
            hc = _layer_norm(DEEPNORM_ALPHA * hc + gate1c * yc, ln1_g[layer], ln1_b[layer])
        f_in = h * (1.0 + scale2) + shift2
        if need_ctx:
            f_in = jnp.concatenate([f_in, hc * (1.0 + scale2c) + shift2c], axis=1)
        i = layer // 2
        if layer % 2 == 0:
            f = _swiglu(f_in, ffn_w_gate[i], ffn_w_up[i], ffn_w_down[i])
        else:
            f = _moe_swiglu(f_in, moe_w_router[i], moe_b_router[i], moe_w_gate[i], moe_w_up[i], moe_w_down[i])
        h = _layer_norm(DEEPNORM_ALPHA * h + gate2 * f[:, :n], ln2_g[layer], ln2_b[layer])
        if need_ctx:
            hc = _layer_norm(DEEPNORM_ALPHA * hc + gate2c * f[:, n:], ln2_g[layer], ln2_b[layer])
    return h
```

```cpp
#include <hip/hip_runtime.h>
#include <stdint.h>
#include <stdio.h>

#ifndef REP_MASK
#define REP_MASK 0
#endif
#ifndef PROBE_PARTS
#define PROBE_PARTS 31
#endif
#ifndef F8GU_MASK
#define F8GU_MASK 3
#endif
#ifndef MK_MULTI
#define MK_MULTI 0
#endif

#define GAS __attribute__((address_space(1)))
#define LAS __attribute__((address_space(3)))
typedef unsigned short bf16;
typedef short bf16x8 __attribute__((ext_vector_type(8)));
typedef float f32x4 __attribute__((ext_vector_type(4)));
typedef float f32x2 __attribute__((ext_vector_type(2)));
typedef unsigned u32x4 __attribute__((ext_vector_type(4)));
typedef unsigned u32x2 __attribute__((ext_vector_type(2)));
typedef int i32x4 __attribute__((ext_vector_type(4)));
typedef int i32x8 __attribute__((ext_vector_type(8)));

constexpr int D = 1024, NB = 8, SEQ = 2048, CTXL = 256, TPB = 2304, NT = NB * TPB;
constexpr int INW = 2048, DFF = 2816, NE = 8, DFE = 3584, DEPTH = 4;
constexpr int NCH = TPB / 16;
constexpr float ALPHA = 1.681792830507429f;
constexpr float LOG2E = 1.4426950408889634f;
constexpr float QSCALE = 0.125f * LOG2E;
constexpr int MAXROWS = 2 * NT + NE * 256;

constexpr size_t MiB = 1u << 20;
constexpr size_t WS_CTL = 0, CTL_BYTES = 2 * MiB;
constexpr size_t WS_MODS = 1 * MiB;
constexpr size_t WS_ROPE = 2 * MiB;
constexpr size_t WS_SSM = 3 * MiB, SSM_LAYER = 5 * MiB;
constexpr size_t SSM_WST = 0, SSM_FF = 2 * MiB, SSM_KC = 2 * MiB + 65536, SSM_G = 2 * MiB + 65536 + 262144, SSM_WGT = SSM_G + 2 * MiB, SSM_PW = SSM_WGT + 131072;
static_assert(SSM_PW + 2 * 16 * 64 * 17 * 8 <= SSM_LAYER, "ssm tables");
constexpr size_t WS_TOKINFO = 23 * MiB;
constexpr size_t WS_STATS = 23 * MiB + 640 * 1024;
constexpr size_t WS_MOUT = 196 * MiB;
constexpr size_t WS_LIST = 24 * MiB;
constexpr size_t WS_IDLIST = 25 * MiB;
constexpr size_t WS_WIN = 26 * MiB;
constexpr size_t WS_WOUT = 42 * MiB;
constexpr size_t WS_WFGU = 50 * MiB;
constexpr size_t WS_WFD = 72 * MiB;
constexpr size_t WS_WMGU = 84 * MiB;
constexpr size_t WS_WMD = 308 * MiB;
constexpr size_t WS_H = 420 * MiB;
constexpr size_t WS_Y = 492 * MiB;
constexpr size_t WS_ABF = 568 * MiB;
constexpr size_t WS_BIG = 604 * MiB;
constexpr size_t WS_KX = 870 * MiB;
constexpr size_t WS_END = 878 * MiB;
constexpr size_t BG_QA = 0, BG_KA = 9 * MiB, BG_VAT = 18 * MiB, BG_QB = 28 * MiB, BG_KB = 37 * MiB, BG_VBT = 42 * MiB, BG_UG = 48 * MiB,
                 BG_QD = 57 * MiB, BG_KD = 66 * MiB, BG_VDT = 71 * MiB, BG_MIX = 77 * MiB, BG_HIN = 113 * MiB, BG_END = 123 * MiB;
static_assert((size_t)MAXROWS * DFE * 2 <= WS_END - WS_BIG && BG_END <= WS_END - WS_BIG, "big region");
constexpr int CW_BAR = 4096;
constexpr int CW_CNT = 16384;
constexpr int CW_LBAR = 24576;
constexpr int CW_XMASK = 28672;
constexpr int CW_Q = 20480;
constexpr int Q_PER = 3 * 112, Q_TOTAL = 16 * Q_PER;

__device__ __forceinline__ unsigned f2bf(float f) { unsigned u = __builtin_bit_cast(unsigned, f); return (u + 0x7fffu + ((u >> 16) & 1u)) >> 16; }
__device__ __forceinline__ unsigned pk2(float lo, float hi) { unsigned r; asm volatile("v_cvt_pk_bf16_f32 %0, %1, %2" : "=v"(r) : "v"(lo), "v"(hi)); return r; }
__device__ __forceinline__ float bf2f(unsigned v) { return __builtin_bit_cast(float, v << 16); }
__device__ __forceinline__ float ex2(float x) { return __builtin_amdgcn_exp2f(x); }
__device__ __forceinline__ float rcpf_(float x) { return __builtin_amdgcn_rcpf(x); }
__device__ __forceinline__ float sigmoidf_(float x) { return rcpf_(1.0f + ex2(-x * LOG2E)); }
__device__ __forceinline__ float siluf_(float x) { return x * sigmoidf_(x); }
__device__ __forceinline__ float gelu_tanh(float x) { const float u = 0.7978845608028654f * (x + 0.044715f * x * x * x); const float t = 1.0f - 2.0f * rcpf_(ex2(2.0f * u * LOG2E) + 1.0f); return 0.5f * x * (1.0f + t); }
__device__ __forceinline__ unsigned cvtpk(float lo, float hi) { unsigned r; asm volatile("v_cvt_pk_bf16_f32 %0, %1, %2" : "=v"(r) : "v"(lo), "v"(hi)); return r; }
__device__ __forceinline__ bf16x8 ldg8(const void* p) { return *(const GAS bf16x8*)p; }
__device__ __forceinline__ void stg2(void* p, u32x2 v) { *(GAS u32x2*)p = v; }
__device__ __forceinline__ void stg4(void* p, u32x4 v) { *(GAS u32x4*)p = v; }
__device__ __forceinline__ f32x4 ldgf4(const void* p) { return *(const GAS f32x4*)p; }
__device__ __forceinline__ void stgf4(void* p, f32x4 v) { *(GAS f32x4*)p = v; }
__device__ __forceinline__ u32x2 ldg2(const void* p) { return *(const GAS u32x2*)p; }
__device__ __forceinline__ f32x4 ldgf4_nt(const void* p) { return __builtin_nontemporal_load((const GAS f32x4*)p); }
__device__ __forceinline__ void stg4_nt(void* p, u32x4 v) { __builtin_nontemporal_store(v, (GAS u32x4*)p); }
__device__ __forceinline__ void stg2_nt(void* p, u32x2 v) { __builtin_nontemporal_store(v, (GAS u32x2*)p); }
__device__ __forceinline__ float clamp8(float x) { return __builtin_fminf(__builtin_fmaxf(x, -448.0f), 448.0f); }
__device__ __forceinline__ unsigned pk4_fp8(float a, float b, float c, float d) { int w = __builtin_amdgcn_cvt_pk_fp8_f32(clamp8(a), clamp8(b), 0, false); w = __builtin_amdgcn_cvt_pk_fp8_f32(clamp8(c), clamp8(d), w, true); return (unsigned)w; }
__device__ __forceinline__ float u2f(unsigned u) { return __builtin_bit_cast(float, u); }
#define LDS_WAIT() asm volatile("s_waitcnt lgkmcnt(0)" ::: "memory")
#define VM_WAIT() asm volatile("s_waitcnt vmcnt(0)" ::: "memory")
__device__ __forceinline__ float xmax4(float x) {
    const unsigned xi = __builtin_bit_cast(unsigned, x);
    const u32x2 r = __builtin_amdgcn_permlane16_swap(xi, xi, false, false);
    const unsigned r0 = r[0], r1 = r[1];
    const float m = fmaxf(u2f(r0), u2f(r1));
    const unsigned mi = __builtin_bit_cast(unsigned, m);
    const u32x2 q = __builtin_amdgcn_permlane32_swap(mi, mi, false, false);
    const unsigned q0 = q[0], q1 = q[1];
    return fmaxf(u2f(q0), u2f(q1));
}
__device__ __forceinline__ float xsum4(float x) {
    const unsigned xi = __builtin_bit_cast(unsigned, x);
    const u32x2 r = __builtin_amdgcn_permlane16_swap(xi, xi, false, false);
    const unsigned r0 = r[0], r1 = r[1];
    const float m = u2f(r0) + u2f(r1);
    const unsigned mi = __builtin_bit_cast(unsigned, m);
    const u32x2 q = __builtin_amdgcn_permlane32_swap(mi, mi, false, false);
    const unsigned q0 = q[0], q1 = q[1];
    return u2f(q0) + u2f(q1);
}
template <int CTRL> __device__ __forceinline__ float dpp_mov(float x) { return __builtin_bit_cast(float, __builtin_amdgcn_mov_dpp(__builtin_bit_cast(int, x), CTRL, 0xf, 0xf, true)); }
__device__ __forceinline__ float wave_sum(float v) {
    v += dpp_mov<0xB1>(v);
    v += dpp_mov<0x4E>(v);
    v += dpp_mov<0x141>(v);
    v += dpp_mov<0x140>(v);
    return xsum4(v);
}
__device__ __forceinline__ void sincos_d(double x, double& s, double& c) {
    const double k = __builtin_rint(x * 0.6366197723675814);
    double r = __builtin_fma(-k, 1.5707963267948966, x);
    r = __builtin_fma(-k, 6.123233995736766e-17, r);
    const double r2 = r * r;
    const double sp = r * (1.0 + r2 * (-1.0 / 6 + r2 * (1.0 / 120 + r2 * (-1.0 / 5040 + r2 * (1.0 / 362880 + r2 * (-1.0 / 39916800 + r2 * (1.0 / 6227020800.0 + r2 * (-1.0 / 1307674368000.0))))))));
    const double cp = 1.0 + r2 * (-0.5 + r2 * (1.0 / 24 + r2 * (-1.0 / 720 + r2 * (1.0 / 40320 + r2 * (-1.0 / 3628800 + r2 * (1.0 / 479001600.0 + r2 * (-1.0 / 87178291200.0 + r2 * (1.0 / 20922789888000.0))))))));
    const int q = ((int)k) & 3;
    s = q == 0 ? sp : q == 1 ? cp : q == 2 ? -sp : -cp;
    c = q == 0 ? cp : q == 1 ? -sp : q == 2 ? -cp : sp;
}

#define XB_TMO      128
#define XB_XCNT(j)  (256  + 64 * (j))
#define XB_XSUB(j)  (1280 + 64 * (j))
#define XB_XGEN(j)  (2304 + 64 * (j))
#define XB_TOP      3328
#define XB_TOPGEN   3392
#define XCD_BAR_WORDS 3456
#define XB_SPIN_CAP (1u << 18)
__device__ __forceinline__ unsigned xb_ld(unsigned* p)              { return __hip_atomic_load(p, __ATOMIC_RELAXED, __HIP_MEMORY_SCOPE_AGENT); }
__device__ __forceinline__ unsigned xb_add(unsigned* p, unsigned v) { return __hip_atomic_fetch_add(p, v, __ATOMIC_RELAXED, __HIP_MEMORY_SCOPE_AGENT); }
__device__ __forceinline__ unsigned xb_xcc_id() { return (unsigned)__builtin_amdgcn_s_getreg((3 << 11) | 20) & 0xFu; }
#define XB_SPIN(cond, bar) do { unsigned _sp = 0; while (cond) { __builtin_amdgcn_s_sleep(1); \
    if ((++_sp & 255u) == 0u) { if (xb_ld(&(bar)[XB_TMO])) break; if (_sp > XB_SPIN_CAP) { atomicAdd(&(bar)[XB_TMO], 1u); break; } } } } while (0)
struct XcdBarrier { unsigned* bar; unsigned x; volatile LAS unsigned* st; };
__device__ __forceinline__ XcdBarrier xcd_barrier_post(unsigned* bar, volatile LAS unsigned* st) {
    XcdBarrier b; b.bar = bar; b.x = xb_xcc_id(); b.st = st;
    if (threadIdx.x == 0) (void)xb_add(&bar[XB_XCNT(b.x)], 1u);
    return b;
}
__device__ __forceinline__ void xcd_barrier_complete(unsigned* bar, unsigned x, unsigned& nloc, unsigned& nx) {
    const unsigned G = gridDim.x * gridDim.y * gridDim.z;
    unsigned sum, cnt, mine, sp = 0u;
    for (;;) {
        sum = 0u; cnt = 0u; mine = 0u;
        unsigned cv[16];
        { const unsigned* p0 = bar + XB_XCNT(0); const unsigned* p1 = bar + XB_XCNT(8);
          asm volatile("global_load_dword %0, %8, off sc1\n\tglobal_load_dword %1, %8, off offset:256 sc1\n\tglobal_load_dword %2, %8, off offset:512 sc1\n\tglobal_load_dword %3, %8, off offset:768 sc1\n\t"
                       "global_load_dword %4, %8, off offset:1024 sc1\n\tglobal_load_dword %5, %8, off offset:1280 sc1\n\tglobal_load_dword %6, %8, off offset:1536 sc1\n\tglobal_load_dword %7, %8, off offset:1792 sc1\n\ts_waitcnt vmcnt(0)"
                       : "=&v"(cv[0]), "=&v"(cv[1]), "=&v"(cv[2]), "=&v"(cv[3]), "=&v"(cv[4]), "=&v"(cv[5]), "=&v"(cv[6]), "=&v"(cv[7]) : "v"(p0) : "memory");
          asm volatile("global_load_dword %0, %8, off sc1\n\tglobal_load_dword %1, %8, off offset:256 sc1\n\tglobal_load_dword %2, %8, off offset:512 sc1\n\tglobal_load_dword %3, %8, off offset:768 sc1\n\t"
                       "global_load_dword %4, %8, off offset:1024 sc1\n\tglobal_load_dword %5, %8, off offset:1280 sc1\n\tglobal_load_dword %6, %8, off offset:1536 sc1\n\tglobal_load_dword %7, %8, off offset:1792 sc1\n\ts_waitcnt vmcnt(0)"
                       : "=&v"(cv[8]), "=&v"(cv[9]), "=&v"(cv[10]), "=&v"(cv[11]), "=&v"(cv[12]), "=&v"(cv[13]), "=&v"(cv[14]), "=&v"(cv[15]) : "v"(p1) : "memory"); }
#pragma unroll
        for (unsigned j = 0; j < 16; ++j) { const unsigned c = cv[j]; sum += c; cnt += (c > 0u) ? 1u : 0u; mine = (j == x) ? c : mine; }
        if (sum == G) break;
        __builtin_amdgcn_s_sleep(1);
        if ((++sp & 255u) == 0u) { if (xb_ld(&bar[XB_TMO])) break; if (sp > XB_SPIN_CAP) { atomicAdd(&bar[XB_TMO], 1u); break; } }
    }
    nloc = mine > 0u ? mine : 1u; nx = cnt > 0u ? cnt : 1u;
}
__device__ __forceinline__ void xcd_barrier(const XcdBarrier& b) {
    asm volatile("s_waitcnt vmcnt(0)" ::: "memory");
    __syncthreads();
    if (threadIdx.x == 0) {
        unsigned* bar = b.bar;
        __builtin_amdgcn_s_waitcnt(0);
        unsigned nloc = b.st[0], nx = b.st[1];
        if (nloc == 0u) { xcd_barrier_complete(bar, b.x, nloc, nx); b.st[0] = nloc; b.st[1] = nx; }
        const unsigned old = xb_add(&bar[XB_XSUB(b.x)], 1u);
        const unsigned gen = old / nloc;
        if (old + 1u == (gen + 1u) * nloc) {
            __builtin_amdgcn_fence(__ATOMIC_RELEASE, "agent");
            asm volatile("s_waitcnt vmcnt(0)" ::: "memory");
            const unsigned og = xb_add(&bar[XB_TOP], 1u);
            const unsigned tg = og / nx;
            if (og + 1u == (tg + 1u) * nx) xb_add(&bar[XB_TOPGEN], 1u);
            else XB_SPIN(xb_ld(&bar[XB_TOPGEN]) == tg, bar);
            __builtin_amdgcn_fence(__ATOMIC_ACQUIRE, "agent");
            xb_add(&bar[XB_XGEN(b.x)], 1u);
            asm volatile("s_waitcnt vmcnt(0)" ::: "memory");
        } else {
            XB_SPIN(xb_ld(&bar[XB_XGEN(b.x)]) == gen, bar);
            __builtin_amdgcn_fence(__ATOMIC_ACQUIRE, "agent");
            asm volatile("s_waitcnt vmcnt(0)" ::: "memory");
        }
    }
    __syncthreads();
}

__device__ __forceinline__ unsigned lb_rmw(unsigned* p, unsigned v) {
    unsigned r; asm volatile("global_atomic_add %0, %1, %2, off sc0\n\ts_waitcnt vmcnt(0)" : "=v"(r) : "v"(p), "v"(v) : "memory"); return r; }
__device__ __forceinline__ void group_barrier(unsigned* bar, unsigned* cnt, volatile LAS unsigned* gen) {
    asm volatile("s_waitcnt vmcnt(0)" ::: "memory");
    __syncthreads();
    if (threadIdx.x == 0) {
        __builtin_amdgcn_s_waitcnt(0);
        const unsigned target = gen[0] + 32u; gen[0] = target;
        (void)lb_rmw(cnt, 1u);
        XB_SPIN(lb_rmw(cnt, 0u) < target, bar);
        __builtin_amdgcn_fence(__ATOMIC_ACQUIRE, "agent");
        asm volatile("s_waitcnt vmcnt(0)" ::: "memory");
    }
    __syncthreads();
}

constexpr int RING_BYTES = 131072;
constexpr int SLDS_BYTES = NCH * 256 * 4;
constexpr int MISC_OFF = SLDS_BYTES;
constexpr int LDS_BYTES = SLDS_BYTES + 1024;
constexpr int NWAVES = 8;

namespace pg8 {
constexpr int BM = 256, BK = 64, HALF = 128, HTB = HALF * BK * 2, NXCD = 8, WGM = 8;
__host__ __device__ __forceinline__ int lds_byte(int r, int c) { const int st = (r >> 4) * 2 + (c >> 5), rr = r & 15, cc = c & 31, ob = rr * 64 + cc * 2; return st * 1024 + (ob ^ (((ob >> 9) & 1) << 5)); }
__host__ __device__ __forceinline__ void stage_rc(int b, int& R, int& C) { const int st = b / 1024, sb = b % 1024, swz = sb ^ (((sb >> 9) & 1) << 5); R = (st >> 1) * 16 + swz / 64; C = (st & 1) * 32 + (swz % 64) / 2; }
__host__ __device__ __forceinline__ int perm32(int rho) { const int n = rho >> 4, i = rho & 15; return 8 * (i >> 2) + 4 * n + (i & 3); }

struct Unit { int pm, pn, e, pbase, cnt; };

struct Sched {
    int nM, nN, nwg, G, c, mode, wgm;
    const int* list; const LAS int* lcnt;
    __device__ __forceinline__ void init(int nM_, int nN_, int G_, int c_, int mode_) { nM = nM_; nN = nN_; nwg = nM * nN; G = G_; c = c_; mode = mode_; wgm = (nM_ == 72) ? 9 : WGM; list = nullptr; lcnt = nullptr; }
    __device__ __forceinline__ void init_cnt(const LAS int* lcnt_, const int* list_, int nN_, int G_, int c_) {
        lcnt = lcnt_; list = list_; int tot = 0;
#pragma unroll
        for (int e = 0; e < 8; ++e) tot += (__builtin_amdgcn_readfirstlane(lcnt_[e]) + 255) >> 8;
        nM = tot; nN = nN_; nwg = nM * nN; G = G_; c = c_; mode = 2; wgm = (tot == 72) ? 9 : WGM;
    }
    __device__ __forceinline__ bool next(int i, Unit& u) const {
        const long L = (long)i * G + c; if (L >= nwg) return false;
        int wgid = (int)L; { const int q = nwg / NXCD, r = nwg % NXCD, xcd = wgid % NXCD, off = wgid / NXCD; wgid = (xcd < r ? xcd * (q + 1) : r * (q + 1) + (xcd - r) * q) + off; }
        const int nig = wgm * nN, gid = wgid / nig, fm = gid * wgm, gsz = (nM - fm) < wgm ? (nM - fm) : wgm;
        const int pmi = fm + ((wgid % nig) % gsz); u.pn = (wgid % nig) / gsz; u.e = 0; u.pbase = 0; u.cnt = 0;
        if (mode == 0) u.pm = pmi;
        else if (mode == 1) u.pm = (pmi >> 3) * 9 + 1 + (pmi & 7);
        else { u.pm = pmi; int acc = 0, e = 0, pbase = 0, cnt = 0; bool found = false;
#pragma unroll
            for (int k = 0; k < 8; ++k) { const int ck = __builtin_amdgcn_readfirstlane(lcnt[k]); const int np = (ck + 255) >> 8;
                if (!found && pmi < acc + np) { found = true; e = k; pbase = acc; cnt = ck; } acc += np; }
            u.e = e; u.pbase = pbase; u.cnt = cnt; }
        return true;
    }
};

__device__ __forceinline__ unsigned cvt_pk_bf16(float lo, float hi) { unsigned r; asm volatile("v_cvt_pk_bf16_f32 %0, %1, %2" : "=v"(r) : "v"(lo), "v"(hi)); return r; }

template <class Epi, bool GATHER, bool F8>
__device__ __forceinline__ void gemm_phase(const int tid, LAS unsigned char* lds, const void* Abase, const void* Btbase, const int KB, const size_t estrideB  , const Sched& S, const Epi& E) {
    const int wid = __builtin_amdgcn_readfirstlane(tid >> 6), lane = tid & 63, wr = wid >> 2, wc = wid & 3, fr = lane & 15, fq = lane >> 4;
    const int nt = KB / 128;
    unsigned voffA[2], voffB[2];
#pragma unroll
    for (int i = 0; i < 2; ++i) { int R, C; stage_rc(tid * 16 + i * 8192, R, C); const int Rb = Epi::PERM ? ((R & ~31) + perm32(R & 31)) : R; voffA[i] = (unsigned)(R * KB + C * 2); voffB[i] = (unsigned)(Rb * KB + C * 2); }
    const size_t kstep = (size_t)(BK * 2);
    const size_t hstep = (size_t)HALF * KB;
    const size_t tstep = 2 * hstep;
    const unsigned ldsw = (unsigned)wid * 1024u;
    const int aoff = lds_byte(wr * 64 + fr, fq * 8), boff = lds_byte(wc * 32 + fr, fq * 8);
#define PG8_SA(b, h) (((b) * 2 + (h)) * HTB)
#define PG8_SB(b, h) ((4 + (b) * 2 + (h)) * HTB)
#define PG8_STAGE(bufoff, gbase, voff) do { _Pragma("unroll") for (int _i = 0; _i < 2; ++_i) \
        __builtin_amdgcn_global_load_lds((const unsigned*)((const char*)(gbase) + (voff)[_i]), (LAS unsigned*)(lds + (bufoff) + ldsw + _i * 8192), 16, 0, 0); } while (0)
#define PG8_STAGE_A(bufoff, gbase, h, NX) do { if constexpr (GATHER) { unsigned _v[2]; _v[0] = (NX) ? vN[h][0] : vC[h][0]; _v[1] = (NX) ? vN[h][1] : vC[h][1]; PG8_STAGE(bufoff, gbase, _v); } \
        else { PG8_STAGE(bufoff, (gbase) + (h) * hstep, voffA); } } while (0)
#define PG8_LDA(dst, b, h) do { _Pragma("unroll") for (int m = 0; m < 4; ++m) _Pragma("unroll") for (int k = 0; k < 2; ++k) dst[m][k] = *(const LAS bf16x8*)(lds + PG8_SA(b, h) + aoff + m * 2048 + k * 1024); } while (0)
#define PG8_LDB(dst, b, h) do { _Pragma("unroll") for (int n = 0; n < 2; ++n) _Pragma("unroll") for (int k = 0; k < 2; ++k) dst[n][k] = *(const LAS bf16x8*)(lds + PG8_SB(b, h) + boff + n * 2048 + k * 1024); } while (0)
#define PG8_MMA(ai, bj, At, Bt) do { __builtin_amdgcn_s_setprio(1); \
        if constexpr (F8) { _Pragma("unroll") for (int m = 0; m < 4; ++m) _Pragma("unroll") for (int n = 0; n < 2; ++n) { \
            const i32x8 _b = __builtin_shufflevector(__builtin_bit_cast(i32x4, Bt[n][0]), __builtin_bit_cast(i32x4, Bt[n][1]), 0, 1, 2, 3, 4, 5, 6, 7); \
            const i32x8 _a = __builtin_shufflevector(__builtin_bit_cast(i32x4, At[m][0]), __builtin_bit_cast(i32x4, At[m][1]), 0, 1, 2, 3, 4, 5, 6, 7); \
            asm volatile("v_mfma_f32_16x16x128_f8f6f4 %0, %1, %2, %0" : "+v"(acc[ai][bj][m][n]) : "v"(_b), "v"(_a)); } } \
        else { _Pragma("unroll") for (int m = 0; m < 4; ++m) _Pragma("unroll") for (int n = 0; n < 2; ++n) _Pragma("unroll") for (int k = 0; k < 2; ++k) \
            acc[ai][bj][m][n] = __builtin_amdgcn_mfma_f32_16x16x32_bf16(Bt[n][k], At[m][k], acc[ai][bj][m][n], 0, 0, 0); } \
        __builtin_amdgcn_s_setprio(0); } while (0)
#define PG8_WAIT_V(n) asm volatile("s_waitcnt vmcnt(" #n ")" ::: "memory")
#define PG8_WAIT_L(n) asm volatile("s_waitcnt lgkmcnt(" #n ")" ::: "memory")
#define PG8_BAR __builtin_amdgcn_s_barrier()
#define PG8_SCHED __builtin_amdgcn_sched_barrier(0)
#define PG8_AIDX(u, tX) do { const int _cnt = (u).cnt; _Pragma("unroll") for (int _h = 0; _h < 2; ++_h) _Pragma("unroll") for (int _i = 0; _i < 2; ++_i) { \
        int _R, _C; stage_rc(tid * 16 + _i * 8192, _R, _C); const int _pos = ((u).pm - (u).pbase) * 256 + _h * 128 + _R; \
        tX[_h][_i] = _pos < _cnt ? S.list[(u).e * NT + _pos] : 0; } } while (0)
#define PG8_AOFS(tX, vX) do { _Pragma("unroll") for (int _h = 0; _h < 2; ++_h) _Pragma("unroll") for (int _i = 0; _i < 2; ++_i) { \
        int _R, _C; stage_rc(tid * 16 + _i * 8192, _R, _C); vX[_h][_i] = (unsigned)(tX[_h][_i] * KB + _C * 2); } } while (0)
    Unit cur, nxt; int ui = 0;
    if (!S.next(0, cur)) return;
    f32x4 acc[2][2][4][2];
#pragma unroll
    for (int a = 0; a < 2; ++a)
#pragma unroll
        for (int b = 0; b < 2; ++b)
#pragma unroll
            for (int m = 0; m < 4; ++m)
#pragma unroll
                for (int n = 0; n < 2; ++n) acc[a][b][m][n] = (f32x4){0.f, 0.f, 0.f, 0.f};
    bf16x8 At[4][2], B0[2][2], B1[2][2];
    unsigned vC[2][2], vN[2][2]; int tI[2][2]; Unit n2; bool has_n2 = false;
    if constexpr (GATHER) {
        PG8_AIDX(cur, tI); PG8_AOFS(tI, vC);
        if (S.next(1, n2)) { PG8_AIDX(n2, tI); PG8_AOFS(tI, vN); } else { PG8_AOFS(tI, vN); }
        VM_WAIT(); }
    const char* cA = (const char*)Abase + (GATHER ? (size_t)0 : (size_t)cur.pm * tstep);
    const char* cB = (const char*)Btbase + (size_t)cur.e * estrideB + (size_t)cur.pn * tstep;
    PG8_STAGE(PG8_SB(0, 0), cB, voffB); PG8_STAGE(PG8_SB(0, 1), cB + hstep, voffB); PG8_STAGE_A(PG8_SA(0, 0), cA, 0, false); PG8_STAGE_A(PG8_SA(0, 1), cA, 1, false);
    if (wr == 1) PG8_BAR;
    PG8_WAIT_V(2); PG8_BAR;
    PG8_STAGE(PG8_SB(1, 0), cB + kstep, voffB); PG8_STAGE_A(PG8_SA(1, 0), cA + kstep, 0, false); PG8_STAGE(PG8_SB(1, 1), cB + hstep + kstep, voffB);
    PG8_WAIT_V(6); PG8_BAR;
    for (;;) {
        const bool has_next = S.next(ui + 1, nxt);
        const char* nA = has_next ? (const char*)Abase + (GATHER ? (size_t)0 : (size_t)nxt.pm * tstep) : cA;
        const char* nB = has_next ? (const char*)Btbase + (size_t)nxt.e * estrideB + (size_t)nxt.pn * tstep : cB;
        for (int t = 0; t < nt; t += 2) {
            const bool last = (t == nt - 2);
            const char* a1 = cA + (size_t)(t + 1) * kstep;
            const char* a2 = last ? nA : cA + (size_t)(t + 2) * kstep; const char* b2 = last ? nB : cB + (size_t)(t + 2) * kstep;
            const char* a3 = a2 + kstep; const char* b3 = b2 + kstep;
            PG8_LDB(B0, 0, 0); PG8_LDB(B1, 0, 1); PG8_SCHED; PG8_LDA(At, 0, 0); PG8_STAGE_A(PG8_SA(1, 1), a1, 1, false);
            PG8_WAIT_V(8); PG8_WAIT_L(0); PG8_BAR; PG8_MMA(0, 0, At, B0); PG8_MMA(0, 1, At, B1); PG8_BAR; PG8_SCHED;
            PG8_LDA(At, 0, 1); PG8_STAGE(PG8_SB(0, 0), b2, voffB); PG8_STAGE(PG8_SB(0, 1), b2 + hstep, voffB); PG8_STAGE_A(PG8_SA(0, 0), a2, 0, last);
            PG8_WAIT_V(8); PG8_WAIT_L(0); PG8_BAR; PG8_MMA(1, 0, At, B0); PG8_MMA(1, 1, At, B1); PG8_BAR; PG8_SCHED;
            PG8_LDB(B0, 1, 0); PG8_LDB(B1, 1, 1); PG8_SCHED; PG8_LDA(At, 1, 0); PG8_STAGE_A(PG8_SA(0, 1), a2, 1, last);
            PG8_WAIT_V(8); PG8_WAIT_L(0); PG8_BAR; PG8_MMA(0, 0, At, B0); PG8_MMA(0, 1, At, B1); PG8_BAR; PG8_SCHED;
            PG8_LDA(At, 1, 1); PG8_STAGE(PG8_SB(1, 0), b3, voffB); PG8_STAGE(PG8_SB(1, 1), b3 + hstep, voffB); PG8_STAGE_A(PG8_SA(1, 0), a3, 0, last);
            PG8_WAIT_V(8); PG8_WAIT_L(0); PG8_BAR; PG8_MMA(1, 0, At, B0); PG8_MMA(1, 1, At, B1); PG8_BAR; PG8_SCHED;
        }
        if (wr == 0) PG8_BAR;
        if constexpr (F8) { asm volatile("s_nop 15\n\ts_nop 15" ::: "memory"); }
        if constexpr (GATHER) { has_n2 = has_next && S.next(ui + 2, n2); if (has_n2) { PG8_AIDX(n2, tI); } }
        { int fr_ = fr, fq_ = fq; asm volatile("" : "+v"(fr_), "+v"(fq_));
          E(acc, cur, wr, wc, fr_, fq_); }
        if (!has_next) break;
#pragma unroll
        for (int a = 0; a < 2; ++a)
#pragma unroll
            for (int b = 0; b < 2; ++b)
#pragma unroll
                for (int m = 0; m < 4; ++m)
#pragma unroll
                    for (int n = 0; n < 2; ++n) acc[a][b][m][n] = (f32x4){0.f, 0.f, 0.f, 0.f};
        cur = nxt; cA = nA; cB = nB; ++ui;
        if constexpr (GATHER) {
#pragma unroll
            for (int h = 0; h < 2; ++h)
#pragma unroll
                for (int i = 0; i < 2; ++i) vC[h][i] = vN[h][i];
            if (has_n2) { PG8_AOFS(tI, vN); } }
        if (wr == 1) PG8_BAR;
    }
    PG8_WAIT_V(0);
    PG8_BAR;
#undef PG8_SA
#undef PG8_SB
#undef PG8_STAGE
#undef PG8_STAGE_A
#undef PG8_LDA
#undef PG8_LDB
#undef PG8_MMA
#undef PG8_WAIT_V
#undef PG8_WAIT_L
#undef PG8_BAR
#undef PG8_SCHED
#undef PG8_AIDX
#undef PG8_AOFS
}
}

struct Args { const float* in[33]; float* out; unsigned char* ws; int ph_lo, ph_hi; };
enum InIdx { I_X = 0, I_C, I_CTX, I_CCTX, I_ADAW, I_ADAB, I_WIN, I_WOUT, I_RPB, I_GQ, I_GK, I_LRE, I_LIM, I_LSTEP, I_BRE, I_BIM, I_CRE, I_CIM, I_SSMD, I_WGLU, I_SINK,
             I_LN1G, I_LN1B, I_LN2G, I_LN2B, I_FG, I_FU, I_FD, I_MR, I_MBR, I_MG, I_MU, I_MD };
struct InTab {
    const LAS unsigned long long* t;
    __device__ __forceinline__ const float* operator[](int i) const { const unsigned long long v = t[i];
        const unsigned lo = __builtin_amdgcn_readfirstlane((unsigned)v), hi = __builtin_amdgcn_readfirstlane((unsigned)(v >> 32)); return (const float*)(((unsigned long long)hi << 32) | lo); }
};
struct Frame {
    LAS unsigned char* lds; int tid, lane, wave, G, gw, NGW, vcu;
    InTab in; float* out; unsigned char* ws;
    unsigned* ctl; float* mods; float* rope; float* H; float* Y; bf16* ABF; unsigned char* big;
};
__device__ __forceinline__ const float* modp(const Frame& F, int layer, int bb, int chunk) { return F.mods + ((size_t)(layer * 9 + bb) * 6 + chunk) * 1024; }

using pg8::Unit;
struct EpiInProj {
    static constexpr bool PERM = true;
    unsigned char* big; const float* gq; const float* gk; const float* rope;
    __device__ __forceinline__ void operator()(f32x4 (&acc)[2][2][4][2], const Unit& u, int wr, int wc, int fr, int fq) const {
        const int b = u.pm / 9, pb = u.pm - b * 9;
        const int pn = u.pn;
        const bool is_v = (pn == 2) || ((pn == 4 || pn == 7) && wc >= 2);
        const bool do_norm = (pn == 3) || (pn == 4 && wc < 2);
        const bool do_rope = (pb != 0) && ((pn == 3) || (pn == 6) || ((pn == 4 || pn == 7) && wc < 2));
        const bool do_qs = (pn == 0) || (pn == 3) || (pn == 6);
        if (do_norm) {
            const float* gn = (pn == 3) ? gq : gk;
            f32x4 g4[2][2];
#pragma unroll
            for (int bj = 0; bj < 2; ++bj)
#pragma unroll
                for (int n = 0; n < 2; ++n) g4[bj][n] = ldgf4(gn + 32 * bj + 8 * fq + 4 * n);
#pragma unroll
            for (int ai = 0; ai < 2; ++ai)
#pragma unroll
                for (int m = 0; m < 4; ++m) {
                    float ss = 0.f;
#pragma unroll
                    for (int bj = 0; bj < 2; ++bj)
#pragma unroll
                        for (int n = 0; n < 2; ++n) { const f32x4 x = acc[ai][bj][m][n]; ss += (x[0] * x[0] + x[1] * x[1]) + (x[2] * x[2] + x[3] * x[3]); }
                    ss += __shfl_xor(ss, 16); ss += __shfl_xor(ss, 32);
                    const float rinv = __builtin_amdgcn_rsqf(ss * (1.0f / 64.0f) + 1e-6f);
#pragma unroll
                    for (int bj = 0; bj < 2; ++bj)
#pragma unroll
                        for (int n = 0; n < 2; ++n) acc[ai][bj][m][n] = acc[ai][bj][m][n] * rinv * g4[bj][n];
                }
        }
        if (do_rope) {
            const float* rp = rope + (size_t)((pb - 1) * 256 + wr * 64 + fr) * 32 + 8 * fq;
#define RP_LOAD(rg, C_, S_) do { _Pragma("unroll") for (int n = 0; n < 2; ++n) { C_[n] = ldgf4(rp + (size_t)(((rg) >> 2) * 128 + ((rg) & 3) * 16) * 32 + 4 * n); S_[n] = ldgf4(rp + 65536 + (size_t)(((rg) >> 2) * 128 + ((rg) & 3) * 16) * 32 + 4 * n); } } while (0)
#define RP_ROT(rg, C_, S_) do { _Pragma("unroll") for (int n = 0; n < 2; ++n) { const f32x4 x1 = acc[(rg) >> 2][0][(rg) & 3][n], x2 = acc[(rg) >> 2][1][(rg) & 3][n]; \
            acc[(rg) >> 2][0][(rg) & 3][n] = x1 * C_[n] - x2 * S_[n]; acc[(rg) >> 2][1][(rg) & 3][n] = x1 * S_[n] + x2 * C_[n]; } } while (0)
            f32x4 cA[2], sA[2], cB[2], sB[2], cC[2], sC[2];
            RP_LOAD(0, cA, sA); RP_LOAD(1, cB, sB); RP_LOAD(2, cC, sC);
            RP_ROT(0, cA, sA); RP_LOAD(3, cA, sA); RP_ROT(1, cB, sB); RP_LOAD(4, cB, sB); RP_ROT(2, cC, sC); RP_LOAD(5, cC, sC);
            RP_ROT(3, cA, sA); RP_LOAD(6, cA, sA); RP_ROT(4, cB, sB); RP_LOAD(7, cB, sB); RP_ROT(5, cC, sC); RP_ROT(6, cA, sA); RP_ROT(7, cB, sB);
#undef RP_LOAD
#undef RP_ROT
        }
        const float qs = do_qs ? QSCALE : 1.0f;
        if (is_v) {
            bf16* vt; int nh, hh;
            if (pn == 2) { vt = (bf16*)(big + BG_VAT); nh = 4; hh = wc; } else if (pn == 4) { vt = (bf16*)(big + BG_VBT); nh = 2; hh = wc - 2; } else { vt = (bf16*)(big + BG_VDT); nh = 2; hh = wc - 2; }
            GAS bf16* vb = (GAS bf16*)(vt + (size_t)(b * nh + hh) * 64 * TPB) + (pb * 8 + wr * 2) * 2048 + (fr >> 3) * 128 + (fr & 7) + (fq >> 1) * 512 + (8 * (fq & 1)) * 8;
#pragma unroll
            for (int ai = 0; ai < 2; ++ai)
#pragma unroll
                for (int m = 0; m < 4; ++m) {
                    const int kb = (4 * ai + (m >> 1)) * 2048 + (m & 1) * 256;
                    const int odd = fr & 1;
#pragma unroll
                    for (int bj = 0; bj < 2; ++bj)
#pragma unroll
                        for (int j = 0; j < 4; ++j) {
                            const float a = acc[ai][bj][m][0][j], c = acc[ai][bj][m][1][j];
                            const float na = dpp_mov<0xB1>(a), nc = dpp_mov<0xB1>(c);
                            const unsigned w = pk2(odd ? nc : a, odd ? c : na);
                            *(GAS unsigned*)(vb + kb + (2 * bj) * 512 + (4 * odd + j) * 8 - odd) = w;
                        }
                }
            return;
        }
        if (pn == 5) {
            bf16* ug = (bf16*)(big + BG_UG) + ((((size_t)(4 * wc + (fq >> 1)) * 72 + u.pm) * 8 + (fr >> 1)) * 64 + (2 * (fr & 1) + (fq & 1)) * 16 + 4 * wr) * 8;
#pragma unroll
            for (int ai = 0; ai < 2; ++ai)
#pragma unroll
                for (int m = 0; m < 4; ++m) {
#pragma unroll
                    for (int bj = 0; bj < 2; ++bj) {
                        const f32x4 v0 = acc[ai][bj][m][0], v1 = acc[ai][bj][m][1];
                        u32x4 w; w.x = pk2(v0[0], v0[1]); w.y = pk2(v0[2], v0[3]); w.z = pk2(v1[0], v1[1]); w.w = pk2(v1[2], v1[3]);
                        stg4(ug + (size_t)(2 * bj) * 72 * 8 * 512 + (8 * ai + m) * 8, w);
                    }
                }
            return;
        }
        if (pn == 0 || pn == 3 || pn == 6) {
            bf16* dst = (bf16*)(big + (pn == 0 ? BG_QA : pn == 3 ? BG_QB : BG_QD));
#pragma unroll
            for (int ai = 0; ai < 2; ++ai)
#pragma unroll
                for (int m = 0; m < 4; ++m) {
                    const size_t row = (size_t)u.pm * 256 + ai * 128 + wr * 64 + m * 16 + fr;
#pragma unroll
                    for (int bj = 0; bj < 2; ++bj) {
                        const f32x4 v0 = acc[ai][bj][m][0] * qs, v1 = acc[ai][bj][m][1] * qs;
                        u32x4 w; w.x = pk2(v0[0], v0[1]); w.y = pk2(v0[2], v0[3]); w.z = pk2(v1[0], v1[1]); w.w = pk2(v1[2], v1[3]);
                        stg4(dst + row * 256 + 64 * wc + 32 * bj + 8 * fq, w);
                    }
                }
            return;
        }
        {
            bf16* kt; int nh;
            if (pn == 1) { kt = (bf16*)(big + BG_KA); nh = 4; } else if (pn == 4) { kt = (bf16*)(big + BG_KB); nh = 2; } else { kt = (bf16*)(big + BG_KD); nh = 2; }
            bf16* kb = kt + (size_t)(b * nh + wc) * 64 * TPB + ((pb * 8 + wr * 2) * 4 + ((fr >> 2) & 1) * 2) * 512 + (fq * 16 + 4 * (fr >> 3) + (fr & 3)) * 8;
#pragma unroll
            for (int ai = 0; ai < 2; ++ai)
#pragma unroll
                for (int m = 0; m < 4; ++m) {
                    const int base = (4 * ai + (m >> 1)) * 2048 + (m & 1) * 64;
#pragma unroll
                    for (int bj = 0; bj < 2; ++bj) {
                        const f32x4 v0 = acc[ai][bj][m][0], v1 = acc[ai][bj][m][1];
                        u32x4 w; w.x = pk2(v0[0], v0[1]); w.y = pk2(v0[2], v0[3]); w.z = pk2(v1[0], v1[1]); w.w = pk2(v1[2], v1[3]);
                        stg4(kb + base + bj * 512, w);
                    }
                }
        }
    }
};
struct EpiResid {
    static constexpr bool PERM = false;
    const float* H; float* Y; const float* mods_layer; int gchunk;
    int src; const float* lng; const float* lnb; const float* stats; float ascale;
    __device__ __forceinline__ void operator()(f32x4 (&acc)[2][2][4][2], const Unit& u, int wr, int wc, int fr, int fq) const {
        const int b = u.pm / 9, pb = u.pm - b * 9, bb = pb == 0 ? 8 : b;
        const int col0 = u.pn * 256 + wc * 32 + 4 * fq;
        const float* gp = mods_layer + ((size_t)bb * 6 + gchunk) * 1024 + col0;
        f32x4 gv[2][2], g4[2][2], b4[2][2];
#pragma unroll
        for (int bj = 0; bj < 2; ++bj)
#pragma unroll
            for (int n = 0; n < 2; ++n) { gv[bj][n] = ldgf4(gp + bj * 128 + n * 16); g4[bj][n] = ldgf4(lng + col0 + bj * 128 + n * 16); b4[bj][n] = ldgf4(lnb + col0 + bj * 128 + n * 16); }
#pragma unroll
        for (int bj = 0; bj < 2; ++bj)
#pragma unroll
            for (int n = 0; n < 2; ++n) { gv[bj][n] = gv[bj][n] * ascale; g4[bj][n] = g4[bj][n] * ALPHA; b4[bj][n] = b4[bj][n] * ALPHA; }
#define ER_ROW(rg) ((size_t)u.pm * 256 + ((rg) >> 2) * 128 + wr * 64 + ((rg) & 3) * 16 + fr)
#define ER_LOAD(sg, Yr, Sr) do { const size_t _row = ER_ROW((sg) >> 1); \
        if (src == 0) { const int _rr = ((sg) >> 3) * 128 + wr * 64 + (((sg) >> 1) & 3) * 16 + fr; \
            const float* _h = (pb == 0 ? lng + ((size_t)b * 256 + _rr) * 1024 : H + ((size_t)b * 2048 + (pb - 1) * 256 + _rr) * 1024) + col0 + ((sg) & 1) * 128;        \
            _Pragma("unroll") for (int n = 0; n < 2; ++n) Yr[n] = ldgf4(_h + n * 16); Sr = (f32x2){0.f, 1.f}; } \
        else { Sr = *(const GAS f32x2*)(stats + 2 * _row); \
            _Pragma("unroll") for (int n = 0; n < 2; ++n) Yr[n] = ldgf4(Y + _row * 1024 + col0 + ((sg) & 1) * 128 + n * 16); } } while (0)
#define ER_CS(sg, Yr, Sr) do { const size_t _off = ER_ROW((sg) >> 1) * 1024 + col0 + ((sg) & 1) * 128; \
        _Pragma("unroll") for (int n = 0; n < 2; ++n) { \
            const f32x4 _h = src == 0 ? Yr[n] * ALPHA : (Yr[n] - Sr[0]) * Sr[1] * g4[(sg) & 1][n] + b4[(sg) & 1][n];        \
            stgf4(Y + _off + n * 16, _h + gv[(sg) & 1][n] * acc[(sg) >> 3][(sg) & 1][((sg) >> 1) & 3][n]); } } while (0)
        f32x4 ya[2], yb[2], yc[2]; f32x2 sa, sb, sc_;
        ER_LOAD(0, ya, sa); ER_LOAD(1, yb, sb); ER_LOAD(2, yc, sc_);
        ER_CS(0, ya, sa); ER_LOAD(3, ya, sa);   ER_CS(1, yb, sb); ER_LOAD(4, yb, sb);   ER_CS(2, yc, sc_); ER_LOAD(5, yc, sc_);
        ER_CS(3, ya, sa); ER_LOAD(6, ya, sa);   ER_CS(4, yb, sb); ER_LOAD(7, yb, sb);   ER_CS(5, yc, sc_); ER_LOAD(8, yc, sc_);
        ER_CS(6, ya, sa); ER_LOAD(9, ya, sa);   ER_CS(7, yb, sb); ER_LOAD(10, yb, sb);  ER_CS(8, yc, sc_); ER_LOAD(11, yc, sc_);
        ER_CS(9, ya, sa); ER_LOAD(12, ya, sa);  ER_CS(10, yb, sb); ER_LOAD(13, yb, sb); ER_CS(11, yc, sc_); ER_LOAD(14, yc, sc_);
        ER_CS(12, ya, sa); ER_LOAD(15, ya, sa); ER_CS(13, yb, sb); ER_CS(14, yc, sc_);  ER_CS(15, ya, sa);
#undef ER_ROW
#undef ER_LOAD
#undef ER_CS
    }
};
template <bool OUT8> struct EpiSwiglu {
    static constexpr bool PERM = true;
    void* act; int ldc; float scale;
    __device__ __forceinline__ void operator()(f32x4 (&acc)[2][2][4][2], const Unit& u, int wr, int wc, int fr, int fq) const {
#pragma unroll
        for (int ai = 0; ai < 2; ++ai)
#pragma unroll
            for (int m = 0; m < 4; ++m) {
                const size_t row = (size_t)u.pm * 256 + ai * 128 + wr * 64 + m * 16 + fr;
                const float k1 = -scale * LOG2E, c2 = scale * scale * (OUT8 ? 8.0f : 1.0f);
                f32x4 o0, o1;
                { const f32x4 G = acc[ai][0][m][0], U = acc[ai][1][m][0]; const f32x4 A = G * k1; f32x4 T; T[0] = ex2(A[0]); T[1] = ex2(A[1]); T[2] = ex2(A[2]); T[3] = ex2(A[3]);
                  const f32x4 D = T + 1.0f; f32x4 R; R[0] = rcpf_(D[0]); R[1] = rcpf_(D[1]); R[2] = rcpf_(D[2]); R[3] = rcpf_(D[3]); o0 = (G * U) * (R * c2); }
                { const f32x4 G = acc[ai][0][m][1], U = acc[ai][1][m][1]; const f32x4 A = G * k1; f32x4 T; T[0] = ex2(A[0]); T[1] = ex2(A[1]); T[2] = ex2(A[2]); T[3] = ex2(A[3]);
                  const f32x4 D = T + 1.0f; f32x4 R; R[0] = rcpf_(D[0]); R[1] = rcpf_(D[1]); R[2] = rcpf_(D[2]); R[3] = rcpf_(D[3]); o1 = (G * U) * (R * c2); }
                if constexpr (OUT8) stg2_nt((unsigned char*)act + row * ldc + u.pn * 128 + wc * 32 + 8 * fq, (u32x2){pk4_fp8(o0[0], o0[1], o0[2], o0[3]), pk4_fp8(o1[0], o1[1], o1[2], o1[3])});
                else { u32x4 w; w.x = pk2(o0[0], o0[1]); w.y = pk2(o0[2], o0[3]); w.z = pk2(o1[0], o1[1]); w.w = pk2(o1[2], o1[3]); stg4((bf16*)act + row * ldc + u.pn * 128 + wc * 32 + 8 * fq, w); }
            }
    }
};
struct EpiBf16Out {
    static constexpr bool PERM = true;
    bf16* O; float scale;
    __device__ __forceinline__ void operator()(f32x4 (&acc)[2][2][4][2], const Unit& u, int wr, int wc, int fr, int fq) const {
#pragma unroll
        for (int ai = 0; ai < 2; ++ai)
#pragma unroll
            for (int m = 0; m < 4; ++m) {
                const size_t row = (size_t)u.pm * 256 + ai * 128 + wr * 64 + m * 16 + fr;
#pragma unroll
                for (int bj = 0; bj < 2; ++bj) {
                    const f32x4 v0 = acc[ai][bj][m][0] * scale, v1 = acc[ai][bj][m][1] * scale;
                    u32x4 w; w.x = pk2(v0[0], v0[1]); w.y = pk2(v0[2], v0[3]); w.z = pk2(v1[0], v1[1]); w.w = pk2(v1[2], v1[3]);
                    stg4_nt(O + row * 1024 + u.pn * 256 + bj * 128 + wc * 32 + 8 * fq, w);
                }
            }
    }
};

__device__ __forceinline__ int slot_of(int mode, int c) {
    if (mode == 0) return c;
    if (mode == 1) { const int tile = c >> 8, lc = c & 255, wc = lc >> 6, d = lc & 63; return tile * 256 + 128 * (d >> 5) + 32 * wc + (d & 31); }
    return 256 * (c >> 7) + (c & 127) + (mode == 3 ? 128 : 0);
}
__device__ __forceinline__ void transpose_tile(const float* W, int K, int Nsrc, bf16* WT, int mode, LAS unsigned* tile, int item, int tid) {
    const int nblk = Nsrc >> 8, kb = item / nblk, nb = item - kb * nblk, k0 = 128 * kb, n0 = 256 * nb;
    const int col4 = tid & 63, rb = tid >> 6;
    const float* src = W + (size_t)(k0 + 2 * rb) * Nsrc + n0 + 4 * col4;
    f32x4 va[8], vb[8];
#pragma unroll
    for (int pp = 0; pp < 8; ++pp) { va[pp] = ldgf4(src + (size_t)(16 * pp) * Nsrc); vb[pp] = ldgf4(src + (size_t)(16 * pp + 1) * Nsrc); }
#pragma unroll
    for (int pp = 0; pp < 8; ++pp) { LAS unsigned* t = tile + (rb + 8 * pp) * 257 + 4 * col4;
        t[0] = pk2(va[pp][0], vb[pp][0]); t[1] = pk2(va[pp][1], vb[pp][1]); t[2] = pk2(va[pp][2], vb[pp][2]); t[3] = pk2(va[pp][3], vb[pp][3]); }
    __syncthreads();
#pragma unroll
    for (int q = 0; q < 8; ++q) {
        const int chunk = q * 512 + tid, c = chunk & 15, n = chunk >> 4;
        const LAS unsigned* t = tile + (4 * c) * 257 + n;
        const u32x4 o = (u32x4){t[0], t[257], t[514], t[771]};
        stg4(WT + (size_t)slot_of(mode, n0 + n) * K + k0 + 8 * c, o);
    }
    __syncthreads();
}
__device__ __forceinline__ void transpose_tile8(const float* W, int K, int Nsrc, unsigned char* WT, int mode, float wscale, LAS unsigned* tile, int item, int tid) {
    const int nblk = Nsrc >> 8, kb = item / nblk, nb = item - kb * nblk, k0 = 128 * kb, n0 = 256 * nb;
    const int col4 = tid & 63, rb = tid >> 6;
    const float* src = W + (size_t)(k0 + 4 * rb) * Nsrc + n0 + 4 * col4;
#pragma unroll
    for (int pp = 0; pp < 4; ++pp) {
        const f32x4 v0 = ldgf4_nt(src + (size_t)(32 * pp) * Nsrc) * wscale, v1 = ldgf4_nt(src + (size_t)(32 * pp + 1) * Nsrc) * wscale, v2 = ldgf4_nt(src + (size_t)(32 * pp + 2) * Nsrc) * wscale, v3 = ldgf4_nt(src + (size_t)(32 * pp + 3) * Nsrc) * wscale;
        LAS unsigned* t = tile + (rb + 8 * pp) * 257 + 4 * col4;
        t[0] = pk4_fp8(v0[0], v1[0], v2[0], v3[0]); t[1] = pk4_fp8(v0[1], v1[1], v2[1], v3[1]); t[2] = pk4_fp8(v0[2], v1[2], v2[2], v3[2]); t[3] = pk4_fp8(v0[3], v1[3], v2[3], v3[3]);
    }
    __syncthreads();
#pragma unroll
    for (int q = 0; q < 4; ++q) {
        const int chunk = q * 512 + tid, c = chunk & 7, n = chunk >> 3;
        const LAS unsigned* t = tile + (4 * c) * 257 + n;
        const u32x4 o = (u32x4){t[0], t[257], t[514], t[771]};
        stg4_nt(WT + (size_t)slot_of(mode, n0 + n) * K + k0 + 16 * c, o);
    }
    __syncthreads();
}
struct SsmP { float lr, li, step; };
struct SsmPtrs { const float* lre; const float* lim; const float* lstep; const float* bre; const float* bim; const float* cre; const float* cim; };
__device__ __forceinline__ SsmP ssm_p(const SsmPtrs& Q, int layer, int d, int g, int p) {
    SsmP r; const int i = ((layer * 2 + d) * 16 + g);
    r.lr = Q.lre[i * 64 + p]; r.li = Q.lim[i * 64 + p]; r.step = ex2(Q.lstep[i] * LOG2E); return r;
}
__device__ __forceinline__ void ssm_apow(const SsmP& q, int kk, float& re, float& im) {
    const float mag = ex2((float)kk * q.lr * q.step * LOG2E);
    double s, c; sincos_d((double)kk * (double)q.li * (double)q.step, s, c);
    re = mag * (float)c; im = mag * (float)s;
}
__device__ __forceinline__ void ssm_f(const SsmP& q, float& fre, float& fim) {
    float are, aim; ssm_apow(q, 1, are, aim);
    const float den = q.lr * q.lr + q.li * q.li, nre = are - 1.0f;
    fre = (nre * q.lr + aim * q.li) / den; fim = (aim * q.lr - nre * q.li) / den;
}

__device__ __forceinline__ void phase_p0a(Frame& F) {
    {
        LAS float* act = (LAS float*)F.lds;
        LAS float* red = act + 9 * 1024;
        const float* cvec = F.in[I_C]; const float* ccx = F.in[I_CCTX]; const float* adaw = F.in[I_ADAW]; const float* adab = F.in[I_ADAB];
        for (int i = F.tid; i < 9 * 1024; i += 512) { const int bb = i >> 10, k = i & 1023; const float x = bb < 8 ? cvec[bb * 1024 + k] : ccx[k]; act[i] = siluf_(x); }
        __syncthreads();
        for (int item = blockIdx.x; item < 4 * 24 * 2; item += F.G) {
            const int kh = item & 1, lc = item >> 1, layer = lc / 24, chunk = lc - layer * 24;
            const float* W = adaw + (size_t)layer * 1024 * 6144 + chunk * 256 + 4 * F.lane;
            f32x4 a0 = {0.f, 0.f, 0.f, 0.f}, a1 = a0, a2 = a0, a3 = a0, a4 = a0, a5 = a0, a6 = a0, a7 = a0, a8 = a0;
            const int k0 = kh * 512 + F.wave * 64;
#pragma unroll 4
            for (int k = k0; k < k0 + 64; k += 4) {
                const f32x4 w0 = ldgf4(W + (size_t)k * 6144), w1 = ldgf4(W + (size_t)(k + 1) * 6144), w2 = ldgf4(W + (size_t)(k + 2) * 6144), w3 = ldgf4(W + (size_t)(k + 3) * 6144);
#define MODS_ACC(ax, bb) { const f32x4 av = *(const LAS f32x4*)(act + bb * 1024 + k); ax += w0 * av[0] + w1 * av[1] + w2 * av[2] + w3 * av[3]; }
                MODS_ACC(a0, 0) MODS_ACC(a1, 1) MODS_ACC(a2, 2) MODS_ACC(a3, 3) MODS_ACC(a4, 4) MODS_ACC(a5, 5) MODS_ACC(a6, 6) MODS_ACC(a7, 7) MODS_ACC(a8, 8)
#undef MODS_ACC
            }
            LAS f32x4* rw = (LAS f32x4*)(red + F.wave * 9 * 256) + F.lane;
            rw[0] = a0; rw[64] = a1; rw[128] = a2; rw[192] = a3; rw[256] = a4; rw[320] = a5; rw[384] = a6; rw[448] = a7; rw[512] = a8;
            __syncthreads();
            for (int o = F.tid; o < 9 * 256; o += 512) { const int bb = o >> 8, nn = o & 255; float sum = kh == 0 ? adab[layer * 6144 + chunk * 256 + nn] : 0.f;
#pragma unroll
                for (int w = 0; w < 8; ++w) sum += red[(w * 9 + bb) * 256 + nn];
                atomicAdd(F.mods + (size_t)(layer * 9 + bb) * 6144 + chunk * 256 + nn, sum); }
            __syncthreads();
        }
    }
    {
        LAS unsigned* tile = (LAS unsigned*)F.lds;
        constexpr int IT_IN = 8 * 8, IT_OUT = 8 * 4, NIT = 4 * (IT_IN + IT_OUT);
        const float* win = F.in[I_WIN]; const float* wout = F.in[I_WOUT];
        for (int it = blockIdx.x; it < NIT; it += F.G) {
            if (it < 4 * IT_IN) { const int l = it / IT_IN, r = it - l * IT_IN; transpose_tile(win + (size_t)l * 1024 * 2048, 1024, 2048, (bf16*)(F.ws + WS_WIN) + (size_t)l * 2048 * 1024, 1, tile, r, F.tid); }
            else { const int q = it - 4 * IT_IN, l = q / IT_OUT, r = q - l * IT_OUT; transpose_tile(wout + (size_t)l * 1024 * 1024, 1024, 1024, (bf16*)(F.ws + WS_WOUT) + (size_t)l * 1024 * 1024, 0, tile, r, F.tid); }
        }
    }
    const SsmPtrs Q{F.in[I_LRE], F.in[I_LIM], F.in[I_LSTEP], F.in[I_BRE], F.in[I_BIM], F.in[I_CRE], F.in[I_CIM]};
    const float* ssmd = F.in[I_SSMD]; const float* wglu = F.in[I_WGLU];
    const int gt = blockIdx.x * 512 + F.tid, NGT = F.G * 512;
    for (int i = gt; i < NT; i += NGT) ((int*)(F.ws + WS_IDLIST))[i] = i;
    if (gt < 192) { const int w = gt >> 6, k = gt & 63; unsigned* pz = (unsigned*)(F.ws + WS_BIG + (w == 0 ? BG_VAT + (size_t)NT * 256 * 2 : w == 1 ? BG_VBT + (size_t)NT * 128 * 2 : BG_VDT + (size_t)NT * 128 * 2)); pz[k] = 0u; }
    for (int i = gt; i < 2048 * 32; i += NGT) {
        const int pos = i >> 5, e = i & 31; const int fi = e & 15;
        const float inv = ex2(-(float)fi * (13.287712379549449f / 16.0f));
        const double ang = (double)(e < 16 ? (pos >> 6) : (pos & 63)) * (double)inv;
        double s, c; sincos_d(ang, s, c);
        F.rope[i] = (float)c; F.rope[65536 + i] = (float)s;
    }
    for (int i = gt; i < 4 * 2 * 16 * 64; i += NGT) {
        const int p = i & 63, g = (i >> 6) & 15, d = (i >> 10) & 1, layer = i >> 11;
        const SsmP q = ssm_p(Q, layer, d, g, p);
        f32x2* pw = (f32x2*)(F.ws + WS_SSM + layer * SSM_LAYER + SSM_PW) + (size_t)((d * 16 + g) * 64 + p) * 17;
#pragma unroll 1
        for (int tau = 0; tau <= 16; ++tau) { float are, aim; ssm_apow(q, tau, are, aim); pw[tau] = (f32x2){are, aim}; }
        float fre, fim; ssm_f(q, fre, fim);
        ((f32x2*)(F.ws + WS_SSM + layer * SSM_LAYER + SSM_FF))[(d * 16 + g) * 64 + p] = (f32x2){fre, fim};
    }
    for (int i = gt; i < 4 * 256 * 256; i += NGT) {
        const int ks = i & 255, o = (i >> 8) & 255, layer = i >> 16;
        const int kap = ks >> 5, fq = (ks >> 3) & 3, jj = ks & 7, ch = (2 * kap + (jj >> 2)) * 16 + 4 * fq + (jj & 3);
        ((GAS bf16*)(F.ws + WS_SSM + layer * SSM_LAYER + SSM_WGT))[(((size_t)(o >> 4) * 8 + kap) * 64 + fq * 16 + (o & 15)) * 8 + jj] = (bf16)f2bf(wglu[(size_t)layer * 65536 + ch * 256 + o]);
    }
}

__device__ __forceinline__ void row_stats(const f32x4 (&v)[4], float& mean, float& rstd) {
    float s = 0.f;
#pragma unroll
    for (int j = 0; j < 4; ++j) s += (v[j][0] + v[j][1]) + (v[j][2] + v[j][3]);
    mean = wave_sum(s) * (1.0f / 1024.0f);
    float s2 = 0.f;
#pragma unroll
    for (int j = 0; j < 4; ++j) { const f32x4 d = v[j] - mean; s2 += (d[0] * d[0] + d[1] * d[1]) + (d[2] * d[2] + d[3] * d[3]); }
    rstd = 1.0f / sqrtf(wave_sum(s2) * (1.0f / 1024.0f) + 1e-6f);
}
__device__ __forceinline__ void store_mod_bf16(bf16* dst, const f32x4 (&h)[4], const float* sc, const float* sh, int lane) {
#pragma unroll
    for (int j = 0; j < 4; ++j) {
        const f32x4 s4 = ldgf4(sc + 256 * j + 4 * lane), t4 = ldgf4(sh + 256 * j + 4 * lane);
        const f32x4 a = h[j] * (s4 + 1.0f) + t4;
        stg2(dst + 256 * j + 4 * lane, (u32x2){pk2(a[0], a[1]), pk2(a[2], a[3])});
    }
}

__device__ __forceinline__ void phase_p0b(Frame& F) {
    const float* xin = F.in[I_X]; const float* cin = F.in[I_CTX];
    const float* fg = F.in[I_FG]; const float* fu = F.in[I_FU]; const float* fd = F.in[I_FD];
    {
        const int R = (NT + F.NGW - 1) / F.NGW, i0 = F.gw * R, i1 = (i0 + R < NT) ? i0 + R : NT;
        f32x4 s4[4], t4[4], vn[4]; int cur_bb = -1;
#pragma unroll
        for (int j = 0; j < 4; ++j) { s4[j] = (f32x4){0.f, 0.f, 0.f, 0.f}; t4[j] = s4[j]; vn[j] = s4[j]; }
#define P0B_SRC(m_) ((m_) % TPB < 256 ? cin + ((size_t)((m_) / TPB) * 256 + (m_) % TPB) * 1024 : xin + ((size_t)((m_) / TPB) * 2048 + ((m_) % TPB - 256)) * 1024)
        if (i0 < i1) { const float* src = P0B_SRC(i0);
#pragma unroll
            for (int j = 0; j < 4; ++j) vn[j] = ldgf4(src + 256 * j + 4 * F.lane); }
        for (int m = i0; m < i1; ++m) {
            const int b = m / TPB, t = m - b * TPB, bb = t < 256 ? 8 : b;
            f32x4 v[4];
#pragma unroll
            for (int j = 0; j < 4; ++j) v[j] = vn[j];
            if (m + 1 < i1) { const float* src = P0B_SRC(m + 1);
#pragma unroll
                for (int j = 0; j < 4; ++j) vn[j] = ldgf4(src + 256 * j + 4 * F.lane); }
            if (bb != cur_bb) { cur_bb = bb; const float* sc = modp(F, 0, bb, 1); const float* sh = modp(F, 0, bb, 0);
#pragma unroll
                for (int j = 0; j < 4; ++j) { s4[j] = ldgf4(sc + 256 * j + 4 * F.lane) + 1.0f; t4[j] = ldgf4(sh + 256 * j + 4 * F.lane); } }
#pragma unroll
            for (int j = 0; j < 4; ++j) { const f32x4 a = v[j] * s4[j] + t4[j]; stg2(F.ABF + (size_t)m * 1024 + 256 * j + 4 * F.lane, (u32x2){pk2(a[0], a[1]), pk2(a[2], a[3])}); }
        }
#undef P0B_SRC
    }
    __syncthreads();
    LAS unsigned* tile = (LAS unsigned*)F.lds;
    constexpr int IT_F = 8 * 11, IT_FD = 22 * 4;
    constexpr int N_F = 2 * (2 * IT_F + IT_FD);
    for (int it = blockIdx.x; it < N_F; it += F.G) {
        const int per = 2 * IT_F + IT_FD, i = it / per; int r = it - i * per;
        bf16* gu = (bf16*)(F.ws + WS_WFGU) + (size_t)i * 5632 * 1024;
        const bool gu8 = ((F8GU_MASK >> i) & 1) != 0;
        if (r < IT_F) { if (gu8) transpose_tile8(fg + (size_t)i * 1024 * DFF, 1024, DFF, (unsigned char*)gu, 2, 128.0f, tile, r, F.tid); else transpose_tile(fg + (size_t)i * 1024 * DFF, 1024, DFF, gu, 2, tile, r, F.tid); }
        else if (r < 2 * IT_F) { if (gu8) transpose_tile8(fu + (size_t)i * 1024 * DFF, 1024, DFF, (unsigned char*)gu, 3, 128.0f, tile, r - IT_F, F.tid); else transpose_tile(fu + (size_t)i * 1024 * DFF, 1024, DFF, gu, 3, tile, r - IT_F, F.tid); }
        else transpose_tile8(fd + (size_t)i * DFF * 1024, DFF, 1024, F.ws + WS_WFD + (size_t)i * 1024 * DFF, 0, 512.0f, tile, r - 2 * IT_F, F.tid);
    }
    const int gt = blockIdx.x * 512 + F.tid, NGT = F.G * 512;
    const float* bre = F.in[I_BRE]; const float* bim_ = F.in[I_BIM]; const float* cre = F.in[I_CRE]; const float* cim_ = F.in[I_CIM]; const float* ssmd = F.in[I_SSMD];
    for (int i = gt; i < 4 * 16 * 2 * 64 * 16; i += NGT) {
        const int j = i & 15, p = (i >> 4) & 63, d = (i >> 10) & 1, g = (i >> 11) & 15, layer = i >> 15;
        const unsigned char* tb = F.ws + WS_SSM + layer * SSM_LAYER; const int dgp = (d * 16 + g) * 64 + p;
        const f32x2 a = ((const f32x2*)(tb + SSM_PW))[(size_t)dgp * 17 + (d == 0 ? 15 - j : j)], f = ((const f32x2*)(tb + SSM_FF))[dgp];
        const float xr = a[0] * f[0] - a[1] * f[1], xi = a[0] * f[1] + a[1] * f[0];
        const size_t bi = ((size_t)((layer * 2 + d) * 16 + g) * 64 + p) * 16;
        const float* br = bre + bi; const float* bm = bim_ + bi;
        bf16* wst = (bf16*)(tb + SSM_WST);
        unsigned wr_[8], wi_[8];
#pragma unroll
        for (int h2 = 0; h2 < 8; ++h2) {
            const float b0r = br[2 * h2], b0i = bm[2 * h2], b1r = br[2 * h2 + 1], b1i = bm[2 * h2 + 1];
            wr_[h2] = pk2(xr * b0r - xi * b0i, xr * b1r - xi * b1i); wi_[h2] = pk2(xr * b0i + xi * b0r, xr * b1i + xi * b1r);
        }
        const int n0 = d * 128 + 2 * p;
#pragma unroll
        for (int c = 0; c < 2; ++c) {
            const int n = n0 + c; const size_t blk = (((size_t)g * 16 + (n >> 4)) * 8 + (j >> 1)) * 512 + (n & 15) * 8;
            stg4(wst + blk + (2 * (j & 1)) * 128, c == 0 ? (u32x4){wr_[0], wr_[1], wr_[2], wr_[3]} : (u32x4){wi_[0], wi_[1], wi_[2], wi_[3]});
            stg4(wst + blk + (2 * (j & 1) + 1) * 128, c == 0 ? (u32x4){wr_[4], wr_[5], wr_[6], wr_[7]} : (u32x4){wi_[4], wi_[5], wi_[6], wi_[7]});
        }
    }
    for (int i = gt; i < 4 * 16 * 16 * 16 * 32; i += NGT) {
        const int p4 = i & 15, d = (i >> 4) & 1, ho = (i >> 5) & 15, ii = (i >> 9) & 15, g = (i >> 13) & 15, layer = i >> 17;
        const unsigned char* tb = F.ws + WS_SSM + layer * SSM_LAYER;
        const size_t cb = ((size_t)((layer * 2 + d) * 16 + g) * 16 + ho) * 64 + 4 * p4;
        const f32x4 cr4 = ldgf4(cre + cb), ci4 = ldgf4(cim_ + cb);
        unsigned w[4];
#pragma unroll
        for (int q = 0; q < 4; ++q) {
            const f32x2 a = ((const f32x2*)(tb + SSM_PW))[(size_t)((d * 16 + g) * 64 + 4 * p4 + q) * 17 + (d == 0 ? ii + 1 : 16 - ii)];
            w[q] = pk2(cr4[q] * a[0] - ci4[q] * a[1], -(cr4[q] * a[1] + ci4[q] * a[0]));
        }
        const int k2 = d * 128 + 8 * p4;
        stg4((bf16*)(tb + SSM_G) + ((((size_t)g * 16 + ii) * 8 + (k2 >> 5)) * 64 + ((k2 & 31) >> 3) * 16 + ho) * 8, (u32x4){w[0], w[1], w[2], w[3]});
    }
    for (int i = gt; i < 4 * 16 * 31 * 16 * 8; i += NGT) {
        const int p8 = i & 7, ho = (i >> 3) & 15; int r = i >> 7; const int dl = r % 31; r /= 31; const int g = r & 15, layer = r >> 4;
        const unsigned char* tb = F.ws + WS_SSM + layer * SSM_LAYER;
        float a[16];
#pragma unroll
        for (int h = 0; h < 16; ++h) a[h] = 0.f;
#pragma unroll 1
        for (int d = 0; d < 2; ++d) {
            if ((d == 0 && dl < 15) || (d == 1 && dl > 15)) continue;
            const int tau = d == 0 ? dl - 15 : 15 - dl; const int dg = d * 16 + g;
            const f32x2* pw = (const f32x2*)(tb + SSM_PW) + (size_t)dg * 64 * 17 + tau; const f32x2* ff = (const f32x2*)(tb + SSM_FF) + dg * 64;
            const float* cr = cre + ((size_t)((layer * 2 + d) * 16 + g) * 16 + ho) * 64; const float* cm = cim_ + ((size_t)((layer * 2 + d) * 16 + g) * 16 + ho) * 64;
            const float* br = bre + ((size_t)((layer * 2 + d) * 16 + g) * 64) * 16; const float* bm = bim_ + ((size_t)((layer * 2 + d) * 16 + g) * 64) * 16;
#pragma unroll 2
            for (int pp = 0; pp < 8; ++pp) {
                const int p = p8 * 8 + pp;
                const f32x2 aw = pw[(size_t)p * 17], f = ff[p];
                const float c0 = cr[p], c1 = cm[p];
                const float wr2 = c0 * aw[0] - c1 * aw[1], wi2 = c0 * aw[1] + c1 * aw[0];
                const float xr = wr2 * f[0] - wi2 * f[1], xi = wr2 * f[1] + wi2 * f[0];
#pragma unroll
                for (int q4 = 0; q4 < 4; ++q4) { const f32x4 rr = ldgf4(br + p * 16 + 4 * q4), mm = ldgf4(bm + p * 16 + 4 * q4);
                    a[4 * q4] += xr * rr[0] - xi * mm[0]; a[4 * q4 + 1] += xr * rr[1] - xi * mm[1]; a[4 * q4 + 2] += xr * rr[2] - xi * mm[2]; a[4 * q4 + 3] += xr * rr[3] - xi * mm[3]; }
            }
        }
#pragma unroll
        for (int h = 0; h < 16; ++h) { a[h] += __shfl_xor(a[h], 1); a[h] += __shfl_xor(a[h], 2); a[h] += __shfl_xor(a[h], 4); }
        if (p8 == 0) {
            if (dl == 15) { const float dsk = ssmd[layer * 256 + g * 16 + ho];
#pragma unroll
                for (int h = 0; h < 16; ++h) a[h] += (h == ho) ? dsk : 0.f; }
            bf16* kc = (bf16*)(tb + SSM_KC) + ((size_t)(g * 31 + dl) * 16 + ho) * 16;
            stg4(kc, (u32x4){pk2(a[0], a[1]), pk2(a[2], a[3]), pk2(a[4], a[5]), pk2(a[6], a[7])});
            stg4(kc + 8, (u32x4){pk2(a[8], a[9]), pk2(a[10], a[11]), pk2(a[12], a[13]), pk2(a[14], a[15])});
        }
    }
}

__device__ __forceinline__ void convert_grab(Frame& F, int quota, int until) {
    LAS int* slot = (LAS int*)(F.lds + MISC_OFF + 192);
    LAS unsigned* tile = (LAS unsigned*)F.lds;
    const float* mg = F.in[I_MG]; const float* mu_ = F.in[I_MU]; const float* md = F.in[I_MD];
    for (int n = 0;; ++n) {
        if (F.tid == 0) { int q = -1;
            if (n < quota || (int)__hip_atomic_load(F.ctl + CW_Q, __ATOMIC_RELAXED, __HIP_MEMORY_SCOPE_AGENT) < until) q = (int)__hip_atomic_fetch_add(F.ctl + CW_Q, 1u, __ATOMIC_RELAXED, __HIP_MEMORY_SCOPE_AGENT);
            *slot = q; }
        __syncthreads();
        const int q = __builtin_amdgcn_readfirstlane(*slot);
        __syncthreads();
        if (q < 0 || q >= Q_TOTAL) break;
        const int ie = q / Q_PER, r = q - ie * Q_PER;
        unsigned char* gu = F.ws + WS_WMGU + (size_t)ie * 7168 * 1024;
        if (r < 112) transpose_tile8(mg + (size_t)ie * 1024 * DFE, 1024, DFE, gu, 2, 128.0f, tile, r, F.tid);
        else if (r < 224) transpose_tile8(mu_ + (size_t)ie * 1024 * DFE, 1024, DFE, gu, 3, 128.0f, tile, r - 112, F.tid);
        else transpose_tile8(md + (size_t)ie * DFE * 1024, DFE, 1024, F.ws + WS_WMD + (size_t)ie * 1024 * DFE, 0, 512.0f, tile, r - 224, F.tid);
    }
}
__device__ __forceinline__ int tail_quota(int nwg, int G, int c, int per_round) { const int mx = (nwg + G - 1) / G, mine = c < nwg ? (nwg - c + G - 1) / G : 0; return (mx - mine) * per_round; }

#define LN_ROW(i) (last ? ((i) >> 11) * TPB + 256 + ((i) & 2047) : (i))
template <bool MOE>
__device__ __forceinline__ void phase_ln1(Frame& F, int layer) {
    constexpr bool moe = MOE; const bool last = (layer == DEPTH - 1);
    const bool f8rows = !MOE && ((F8GU_MASK >> (layer >> 1)) & 1) != 0;
    const int nrows = last ? NB * SEQ : NT;
    const float* lg = F.in[I_LN1G] + layer * 1024; const float* lb = F.in[I_LN1B] + layer * 1024;
    LAS int* lcnt = (LAS int*)(F.lds);
    LAS int* rinfo = (LAS int*)(F.lds + 256);
    LAS int* nloc = (LAS int*)(F.lds + 128);
    if (moe) { convert_grab(F, 0, (layer >> 1) == 0 ? Q_TOTAL / 2 : Q_TOTAL); __syncthreads(); if (F.tid < 16) lcnt[F.tid] = 0; if (F.tid == 16) nloc[0] = 0; __syncthreads(); }
    const float* wr_ = F.in[I_MR] + (size_t)(layer >> 1) * 1024 * 8; const float* br_ = F.in[I_MBR] + (layer >> 1) * 8;
    const int R = (nrows + F.NGW - 1) / F.NGW, i0 = F.gw * R, i1 = (i0 + R < nrows) ? i0 + R : nrows;
    f32x4 g4[4], s4[4], t4[4];
#pragma unroll
    for (int j = 0; j < 4; ++j) { g4[j] = ldgf4(lg + 256 * j + 4 * F.lane); s4[j] = g4[j]; t4[j] = g4[j]; }
    f32x4 rw[4][4][2];
#pragma unroll
    for (int j = 0; j < 4; ++j)
#pragma unroll
        for (int q = 0; q < 4; ++q) { rw[j][q][0] = g4[j]; rw[j][q][1] = g4[j]; }
    if (moe) {
#pragma unroll
        for (int j = 0; j < 4; ++j)
#pragma unroll
            for (int q = 0; q < 4; ++q) { const float* w = wr_ + (size_t)(256 * j + 4 * F.lane + q) * 8; rw[j][q][0] = ldgf4(w); rw[j][q][1] = ldgf4(w + 4); } }
    int cur_bb = -1;
#define LN1_LOADROW(buf, ii) do { const int _m = LN_ROW(ii); _Pragma("unroll") for (int j = 0; j < 4; ++j) buf[j] = ldgf4(F.Y + (size_t)_m * 1024 + 256 * j + 4 * F.lane); } while (0)
    auto ln1_row = [&](f32x4 (&v)[4], const int idx) __attribute__((always_inline)) {
        const int m = LN_ROW(idx);
        const int b = m / TPB, t = m - b * TPB, bb = t < 256 ? 8 : b;
        if (bb != cur_bb) { cur_bb = bb; const float* sc = modp(F, layer, bb, 4); const float* sh = modp(F, layer, bb, 3);
#pragma unroll
            for (int j = 0; j < 4; ++j) { const f32x4 s1 = ldgf4(sc + 256 * j + 4 * F.lane) + 1.0f; s4[j] = ldgf4(lg + 256 * j + 4 * F.lane) * s1; t4[j] = ldgf4(lb + 256 * j + 4 * F.lane) * s1 + ldgf4(sh + 256 * j + 4 * F.lane); } }
        float mean, rstd; row_stats(v, mean, rstd);
        if (F.lane == 0) *(GAS f32x2*)((float*)(F.ws + WS_STATS) + 2 * (size_t)m) = (f32x2){mean, rstd};
        f32x4 f[4];
#pragma unroll
        for (int j = 0; j < 4; ++j) {
            f[j] = (v[j] - mean) * rstd * s4[j] + t4[j];
            if (moe || f8rows) *(GAS unsigned*)((unsigned char*)F.ABF + (size_t)m * 1024 + 256 * j + 4 * F.lane) = pk4_fp8(f[j][0] * 16.0f, f[j][1] * 16.0f, f[j][2] * 16.0f, f[j][3] * 16.0f);
            else stg2(F.ABF + (size_t)m * 1024 + 256 * j + 4 * F.lane, (u32x2){pk2(f[j][0], f[j][1]), pk2(f[j][2], f[j][3])});
        }
        if (moe) {
            float lgt[8];
#pragma unroll
            for (int e = 0; e < 8; ++e) lgt[e] = 0.f;
#pragma unroll
            for (int j = 0; j < 4; ++j)
#pragma unroll
                for (int q = 0; q < 4; ++q) {
                    const f32x4 w0 = rw[j][q][0], w1 = rw[j][q][1]; const float x = f[j][q];
                    lgt[0] += x * w0[0]; lgt[1] += x * w0[1]; lgt[2] += x * w0[2]; lgt[3] += x * w0[3]; lgt[4] += x * w1[0]; lgt[5] += x * w1[1]; lgt[6] += x * w1[2]; lgt[7] += x * w1[3];
                }
#pragma unroll
            for (int e = 0; e < 8; ++e) lgt[e] = wave_sum(lgt[e]) + br_[e];
            int e0 = 0; float l0 = lgt[0];
#pragma unroll
            for (int e = 1; e < 8; ++e) if (lgt[e] > l0) { l0 = lgt[e]; e0 = e; }
            int e1 = -1; float l1 = -3.0e38f;
#pragma unroll
            for (int e = 0; e < 8; ++e) if (e != e0 && lgt[e] > l1) { l1 = lgt[e]; e1 = e; }
            const float w1 = 1.0f / (1.0f + ex2((l0 - l1) * LOG2E)), w0 = 1.0f - w1;
            if (F.lane == 0) {
                const int slot = __hip_atomic_fetch_add(nloc, 1, __ATOMIC_RELAXED, __HIP_MEMORY_SCOPE_WORKGROUP); const int p0 = __hip_atomic_fetch_add(&lcnt[e0], 1, __ATOMIC_RELAXED, __HIP_MEMORY_SCOPE_WORKGROUP), p1 = __hip_atomic_fetch_add(&lcnt[e1], 1, __ATOMIC_RELAXED, __HIP_MEMORY_SCOPE_WORKGROUP);
                LAS int* ri = rinfo + slot * 8; ri[0] = m; ri[1] = e0; ri[2] = p0; ri[3] = e1; ri[4] = p1; ri[5] = __builtin_bit_cast(int, w0); ri[6] = __builtin_bit_cast(int, w1);
            }
        }
        };
    f32x4 vA[4], vB[4], vC[4];
#pragma unroll
    for (int j = 0; j < 4; ++j) { vA[j] = (f32x4){0.f, 0.f, 0.f, 0.f}; vB[j] = vA[j]; vC[j] = vA[j]; }
    if (MOE) {
        if (i0 < i1) LN1_LOADROW(vA, i0);
        for (int idx = i0; idx < i1; ++idx) {
#pragma unroll
            for (int j = 0; j < 4; ++j) vB[j] = vA[j];
            if (idx + 1 < i1) LN1_LOADROW(vA, idx + 1);
            ln1_row(vB, idx);
        }
    } else {
        if (i0 < i1) {
            const int il = i1 - 1; int idx = i0;
            LN1_LOADROW(vA, i0); LN1_LOADROW(vB, (i0 + 1 < il ? i0 + 1 : il)); LN1_LOADROW(vC, (i0 + 2 < il ? i0 + 2 : il));
            for (; idx + 3 <= i1; idx += 3) {
                ln1_row(vA, idx);     LN1_LOADROW(vA, (idx + 3 < il ? idx + 3 : il));
                ln1_row(vB, idx + 1); LN1_LOADROW(vB, (idx + 4 < il ? idx + 4 : il));
                ln1_row(vC, idx + 2); LN1_LOADROW(vC, (idx + 5 < il ? idx + 5 : il));
            }
            if (idx < i1) { ln1_row(vA, idx); if (idx + 1 < i1) ln1_row(vB, idx + 1); }
        }
    }
#undef LN1_LOADROW
    if (moe) {
        unsigned* gcnt = F.ctl + CW_CNT + (layer >> 1) * 64;
        __syncthreads();
        if (F.tid < 8) lcnt[8 + F.tid] = (int)__hip_atomic_fetch_add(gcnt + F.tid, (unsigned)lcnt[F.tid], __ATOMIC_RELAXED, __HIP_MEMORY_SCOPE_AGENT);
        __syncthreads();
        const int n = nloc[0]; int* list = (int*)(F.ws + WS_LIST); int* tinfo = (int*)(F.ws + WS_TOKINFO);
        for (int s = F.tid; s < n; s += 512) {
            const LAS int* ri = rinfo + s * 8; const int m = ri[0], e0 = ri[1], e1 = ri[3], q0 = lcnt[8 + e0] + ri[2], q1 = lcnt[8 + e1] + ri[4];
            list[e0 * NT + q0] = m; list[e1 * NT + q1] = m;
            stg4(tinfo + (size_t)m * 8, (u32x4){(unsigned)e0, (unsigned)q0, (unsigned)e1, (unsigned)q1}); tinfo[(size_t)m * 8 + 4] = ri[5]; tinfo[(size_t)m * 8 + 5] = ri[6];
        }
    }
}
__device__ __forceinline__ void phase_ln2(Frame& F, int layer) {
    const bool moe = (layer & 1) != 0, last = (layer == DEPTH - 1);
    const int nrows = last ? NB * SEQ : NT;
    const float* lg = F.in[I_LN2G] + layer * 1024; const float* lb = F.in[I_LN2B] + layer * 1024;
    int pof[8];
    if (moe) { const unsigned* gcnt = F.ctl + CW_CNT + (layer >> 1) * 64; int acc = 0;
#pragma unroll
        for (int e = 0; e < 8; ++e) { pof[e] = acc; acc += (((int)__hip_atomic_load(gcnt + e, __ATOMIC_RELAXED, __HIP_MEMORY_SCOPE_AGENT) + 255) >> 8) << 8; } }
    const bf16* mout = (const bf16*)(F.ws + WS_MOUT); const int* tinfo = (const int*)(F.ws + WS_TOKINFO);
    const float* lg1 = F.in[I_LN1G] + layer * 1024; const float* lb1 = F.in[I_LN1B] + layer * 1024;
    const float* st1 = (const float*)(F.ws + WS_STATS); float* st2 = (float*)(F.ws + WS_STATS) + 2 * NT;
    const int R = (nrows + F.NGW - 1) / F.NGW, i0 = F.gw * R, i1 = (i0 + R < nrows) ? i0 + R : nrows;
    f32x4 g4[4], b4[4], g1[4], b1[4], gt2[4], s4[4], t4[4];
#pragma unroll
    for (int j = 0; j < 4; ++j) { g4[j] = ldgf4(lg + 256 * j + 4 * F.lane); b4[j] = ldgf4(lb + 256 * j + 4 * F.lane); g1[j] = g4[j]; b1[j] = g4[j]; gt2[j] = g4[j]; s4[j] = g4[j]; t4[j] = g4[j]; }
    if (moe) {
#pragma unroll
        for (int j = 0; j < 4; ++j) { g1[j] = ldgf4(lg1 + 256 * j + 4 * F.lane); b1[j] = ldgf4(lb1 + 256 * j + 4 * F.lane); } }
    int cur_bb = -1;
    u32x4 tiN = (u32x4){0u, 0u, 0u, 0u}, tiN2 = tiN; u32x2 twN = (u32x2){0u, 0u}, twN2 = twN; f32x2 s1N = (f32x2){0.f, 0.f};
    u32x2 maN[4], mcN[4];
#pragma unroll
    for (int j = 0; j < 4; ++j) { maN[j] = (u32x2){0u, 0u}; mcN[j] = maN[j]; }
#define LN2_ROWS(ti_, ma_, mc_) do { int _o0 = 0, _o1 = 0; _Pragma("unroll") for (int e = 0; e < 8; ++e) { _o0 = ((int)(ti_).x == e) ? pof[e] : _o0; _o1 = ((int)(ti_).z == e) ? pof[e] : _o1; } \
        const bf16* _r0 = mout + (size_t)(_o0 + (int)(ti_).y) * 1024; const bf16* _r1 = mout + (size_t)(_o1 + (int)(ti_).w) * 1024; \
        _Pragma("unroll") for (int j = 0; j < 4; ++j) { ma_[j] = ldg2(_r0 + 256 * j + 4 * F.lane); mc_[j] = ldg2(_r1 + 256 * j + 4 * F.lane); } } while (0)
    if (moe && i0 < i1) { const int m0 = LN_ROW(i0);
        tiN = *(const GAS u32x4*)(tinfo + (size_t)m0 * 8); twN = *(const GAS u32x2*)(tinfo + (size_t)m0 * 8 + 4); s1N = *(const GAS f32x2*)(st1 + 2 * (size_t)m0);
        { const int m1 = LN_ROW((i0 + 1 < i1 ? i0 + 1 : i1 - 1)); tiN2 = *(const GAS u32x4*)(tinfo + (size_t)m1 * 8); twN2 = *(const GAS u32x2*)(tinfo + (size_t)m1 * 8 + 4); }
        LN2_ROWS(tiN, maN, mcN); }
#define LN2_LOADROW(buf, ii) do { const int _m = LN_ROW(ii); _Pragma("unroll") for (int j = 0; j < 4; ++j) buf[j] = ldgf4(F.Y + (size_t)_m * 1024 + 256 * j + 4 * F.lane); } while (0)
    auto ln2_row = [&](f32x4 (&v)[4], const int idx) __attribute__((always_inline)) {
        const int m = LN_ROW(idx);
        const int b = m / TPB, t = m - b * TPB, bb = t < 256 ? 8 : b;
        if (bb != cur_bb) { cur_bb = bb;
            if (moe) { const float* g2 = modp(F, layer, bb, 5);
#pragma unroll
                for (int j = 0; j < 4; ++j) gt2[j] = ldgf4(g2 + 256 * j + 4 * F.lane); }
            if (!last) { const float* sc = modp(F, layer + 1, bb, 1); const float* sh = modp(F, layer + 1, bb, 0);
#pragma unroll
                for (int j = 0; j < 4; ++j) { s4[j] = ldgf4(sc + 256 * j + 4 * F.lane) + 1.0f; t4[j] = ldgf4(sh + 256 * j + 4 * F.lane); } } }
        if (moe) {
            const u32x2 tw = twN; const unsigned twx = tw.x, twy = tw.y;
            const float w0 = u2f(twx), w1 = u2f(twy);
            const f32x2 s1 = s1N;
            u32x2 ma[4], mc[4];
#pragma unroll
            for (int j = 0; j < 4; ++j) { ma[j] = maN[j]; mc[j] = mcN[j]; }
            tiN = tiN2; twN = twN2;
            { const int m1 = LN_ROW((idx + 1 < i1 ? idx + 1 : i1 - 1)); s1N = *(const GAS f32x2*)(st1 + 2 * (size_t)m1); LN2_ROWS(tiN, maN, mcN); }
            { const int m2 = LN_ROW((idx + 2 < i1 ? idx + 2 : i1 - 1)); tiN2 = *(const GAS u32x4*)(tinfo + (size_t)m2 * 8); twN2 = *(const GAS u32x2*)(tinfo + (size_t)m2 * 8 + 4); }
#pragma unroll
            for (int j = 0; j < 4; ++j) {
                const u32x2 a = ma[j], c = mc[j];
                const f32x4 fa = (f32x4){bf2f(a.x & 0xffffu), bf2f(a.x >> 16), bf2f(a.y & 0xffffu), bf2f(a.y >> 16)}, fc = (f32x4){bf2f(c.x & 0xffffu), bf2f(c.x >> 16), bf2f(c.y & 0xffffu), bf2f(c.y >> 16)};
                const f32x4 h = (v[j] - s1[0]) * s1[1] * g1[j] + b1[j];
                v[j] = h * ALPHA + gt2[j] * (fa * w0 + fc * w1);
                if (!last) stgf4(F.Y + (size_t)m * 1024 + 256 * j + 4 * F.lane, v[j]);
            }
        }
        float mean, rstd; row_stats(v, mean, rstd);
        if (!last && F.lane == 0) *(GAS f32x2*)(st2 + 2 * (size_t)m) = (f32x2){mean, rstd};
#pragma unroll
        for (int j = 0; j < 4; ++j) v[j] = (v[j] - mean) * rstd * g4[j] + b4[j];
        if (last) {
#pragma unroll
            for (int j = 0; j < 4; ++j) stgf4(F.out + ((size_t)b * 2048 + (t - 256)) * 1024 + 256 * j + 4 * F.lane, v[j]);
        } else {
#pragma unroll
            for (int j = 0; j < 4; ++j) { const f32x4 a = v[j] * s4[j] + t4[j]; stg2(F.ABF + (size_t)m * 1024 + 256 * j + 4 * F.lane, (u32x2){pk2(a[0], a[1]), pk2(a[2], a[3])}); }
        }
    };
    f32x4 vA[4], vB[4], vC[4];
#pragma unroll
    for (int j = 0; j < 4; ++j) { vA[j] = (f32x4){0.f, 0.f, 0.f, 0.f}; vB[j] = vA[j]; vC[j] = vA[j]; }
    if (i0 < i1) {
        const int il = i1 - 1; int idx = i0;
        LN2_LOADROW(vA, i0); LN2_LOADROW(vB, (i0 + 1 < il ? i0 + 1 : il)); LN2_LOADROW(vC, (i0 + 2 < il ? i0 + 2 : il));
        for (; idx + 3 <= i1; idx += 3) {
            ln2_row(vA, idx);     LN2_LOADROW(vA, (idx + 3 < il ? idx + 3 : il));
            ln2_row(vB, idx + 1); LN2_LOADROW(vB, (idx + 4 < il ? idx + 4 : il));
            ln2_row(vC, idx + 2); LN2_LOADROW(vC, (idx + 5 < il ? idx + 5 : il));
        }
        if (idx < i1) { ln2_row(vA, idx); if (idx + 1 < i1) ln2_row(vB, idx + 1); }
    }
#undef LN2_LOADROW
}
#undef LN_ROW
#undef LN2_ROWS
struct AttnP {
    const bf16* q0; const bf16* q1;
    const bf16* K; int kstride;
    const bf16* Vt;
    bf16* o0; bf16* o1;
    int nfull; int has_sink; float sink0, sink1;
    int jg;
    int r, g4; const LAS float* rpb;
};
template <int NG, int MODE>
__device__ __forceinline__ void attn_item(const AttnP& P, int lane) {
    const int fr = lane & 15, fq = lane >> 4;
    bf16x8 qf[NG][2];
#pragma unroll
    for (int ks = 0; ks < 2; ++ks) { qf[0][ks] = ldg8(P.q0 + 32 * ks + 8 * fq); if (NG == 2) qf[NG - 1][ks] = ldg8(P.q1 + 32 * ks + 8 * fq); }
    f32x4 O[NG][4]; float mrun[NG], lrun[NG];
#pragma unroll
    for (int g = 0; g < NG; ++g) { mrun[g] = -1e30f; lrun[g] = 0.f;
#pragma unroll
        for (int dt = 0; dt < 4; ++dt) O[g][dt] = (f32x4){0.f, 0.f, 0.f, 0.f}; }
    int u_lo = 0, nloc = 0, rs = 0, h_lo = 0, nh = 1;
    if (MODE == 1) { int lo = 16 * P.jg - 128; lo = lo < 0 ? 0 : lo; int hi = 16 * P.jg + 143; hi = hi > SEQ - 1 ? SEQ - 1 : hi; u_lo = lo >> 5; nloc = (hi >> 5) - u_lo + 1; }
    if (MODE == 2) { rs = P.r - 4; rs = rs < 0 ? 0 : (rs > 24 ? 24 : rs); h_lo = P.g4 == 3 ? 1 : 0; nh = (P.g4 == 1 || P.g4 == 2) ? 2 : 1; nloc = 8 * nh; }
    const int nfull = P.nfull, ns = nfull + nloc;
    const char* Kb = (const char*)P.K + lane * 16; const char* Vb = (const char*)P.Vt + lane * 16;
    const int qc = 16 * P.g4 + fr; int cs = qc - 8; cs = cs < 0 ? 0 : (cs > 48 ? 48 : cs);
#define ATT_ST(s) ((s) < nfull ? (s) : (MODE == 1 ? 8 + u_lo + ((s) - nfull) : (nh == 2 ? 8 + 2 * rs + ((s) - nfull) : 8 + 2 * (rs + ((s) - nfull)) + h_lo)))
#define ATT_LOAD(kf, vf, bs, s_) do { const int _st = ATT_ST(s_); const char* _kp = Kb + (size_t)_st * 4096; const char* _vp = Vb + (size_t)_st * 4096; \
        kf[0][0] = ldg8(_kp); kf[0][1] = ldg8(_kp + 1024); kf[1][0] = ldg8(_kp + 2048); kf[1][1] = ldg8(_kp + 3072); \
        vf[0] = ldg8(_vp); vf[1] = ldg8(_vp + 1024); vf[2] = ldg8(_vp + 2048); vf[3] = ldg8(_vp + 3072); \
        if (MODE == 2) { if ((s_) >= nfull) { const int _l = _st - 8, _br = _l >> 1, _hf = _l & 1; const LAS float* _rp = P.rpb + (_br - P.r + 7) * 31 + 15; \
            _Pragma("unroll") for (int e = 0; e < 8; ++e) { int dc = 32 * _hf + 8 * fq + e - qc; dc = dc < -15 ? -15 : (dc > 15 ? 15 : dc); bs[e] = _rp[dc]; } } } } while (0)
#define ATT_STEP(kf, vf, bs, s_) do { \
        f32x4 sc[NG][2]; \
        _Pragma("unroll") for (int g = 0; g < NG; ++g) _Pragma("unroll") for (int t = 0; t < 2; ++t) { \
            f32x4 a = MODE == 3 ? (f32x4){-16.f, -16.f, -16.f, -16.f} : (f32x4){0.f, 0.f, 0.f, 0.f};        \
            a = __builtin_amdgcn_mfma_f32_16x16x32_bf16(kf[t][0], qf[g][0], a, 0, 0, 0); \
            a = __builtin_amdgcn_mfma_f32_16x16x32_bf16(kf[t][1], qf[g][1], a, 0, 0, 0); sc[g][t] = a; } \
        if (MODE == 1 && (s_) >= nfull) { \
            const int _kp0 = 32 * (ATT_ST(s_) - 8); \
            if (!(_kp0 >= 16 * P.jg + 15 - 128 && _kp0 + 31 <= 16 * P.jg + 128)) {           \
                const int qpos = 16 * P.jg + fr; \
                _Pragma("unroll") for (int t = 0; t < 2; ++t) _Pragma("unroll") for (int j = 0; j < 4; ++j) { \
                    const int dd = _kp0 + 8 * fq + 4 * t + j - qpos; const bool ok = dd <= 128 && dd >= -128; \
                    _Pragma("unroll") for (int g = 0; g < NG; ++g) sc[g][t][j] = ok ? sc[g][t][j] : -1e30f; } } } \
        if (MODE == 2 && (s_) >= nfull) { \
            const int _hf = (ATT_ST(s_) - 8) & 1; \
            _Pragma("unroll") for (int t = 0; t < 2; ++t) _Pragma("unroll") for (int j = 0; j < 4; ++j) { \
                const int kc = 32 * _hf + 8 * fq + 4 * t + j; \
                sc[0][t][j] = (kc >= cs && kc < cs + 16) ? sc[0][t][j] + bs[4 * t + j] : -1e30f; } } \
        bf16x8 pf[NG]; \
        _Pragma("unroll") for (int g = 0; g < NG; ++g) { \
            float p[8]; float ls = 0.f; \
            if (MODE == 3) {                                                               \
                _Pragma("unroll") for (int t = 0; t < 2; ++t) _Pragma("unroll") for (int j = 0; j < 4; ++j) { p[4 * t + j] = ex2(sc[g][t][j]); ls += p[4 * t + j]; } \
            } else { \
            float mx = fmaxf(fmaxf(fmaxf(sc[g][0][0], sc[g][0][1]), fmaxf(sc[g][0][2], sc[g][0][3])), fmaxf(fmaxf(sc[g][1][0], sc[g][1][1]), fmaxf(sc[g][1][2], sc[g][1][3]))); \
            mx = xmax4(mx); \
            const float mn = fmaxf(mrun[g], mx); \
            if (__builtin_amdgcn_ballot_w64(mn > mrun[g]) != 0ull) { \
                const float al = ex2(mrun[g] - mn); lrun[g] *= al; \
                _Pragma("unroll") for (int dt = 0; dt < 4; ++dt) O[g][dt] = O[g][dt] * al; } \
            mrun[g] = mn; \
            _Pragma("unroll") for (int t = 0; t < 2; ++t) _Pragma("unroll") for (int j = 0; j < 4; ++j) { p[4 * t + j] = ex2(sc[g][t][j] - mn); ls += p[4 * t + j]; } \
            } \
            lrun[g] += ls; \
            const u32x4 pw = (u32x4){cvtpk(p[0], p[1]), cvtpk(p[2], p[3]), cvtpk(p[4], p[5]), cvtpk(p[6], p[7])}; \
            pf[g] = __builtin_bit_cast(bf16x8, pw); } \
          \
        if (NG == 2) asm volatile("s_nop 1" : "+v"(pf[0]), "+v"(pf[NG - 1])); else asm volatile("s_nop 1" : "+v"(pf[0])); \
        _Pragma("unroll") for (int dt = 0; dt < 4; ++dt) _Pragma("unroll") for (int g = 0; g < NG; ++g) O[g][dt] = __builtin_amdgcn_mfma_f32_16x16x32_bf16(vf[dt], pf[g], O[g][dt], 0, 0, 0); } while (0)
    bf16x8 kfA[2][2], vfA[4], kfB[2][2], vfB[4]; float bsA[8], bsB[8];
#pragma unroll
    for (int e = 0; e < 8; ++e) { bsA[e] = 0.f; bsB[e] = 0.f; }
    ATT_LOAD(kfA, vfA, bsA, 0);
    for (int s = 0; s < ns; s += 2) {
        { const int sn = s + 1 < ns ? s + 1 : ns - 1; ATT_LOAD(kfB, vfB, bsB, sn); }
        ATT_STEP(kfA, vfA, bsA, s);
        if (s + 1 < ns) {
            { const int sn = s + 2 < ns ? s + 2 : ns - 1; ATT_LOAD(kfA, vfA, bsA, sn); }
            ATT_STEP(kfB, vfB, bsB, s + 1);
        }
    }
#pragma unroll
    for (int g = 0; g < NG; ++g) {
        float l = xsum4(lrun[g]);
        if (P.has_sink) l += ex2((g == 0 ? P.sink0 : P.sink1) * LOG2E - mrun[g]);
        const float inv = rcpf_(l); bf16* o = g == 0 ? P.o0 : P.o1;
#pragma unroll
        for (int dt = 0; dt < 4; ++dt) { const f32x4 v = O[g][dt] * inv; stg2(o + 16 * dt + 4 * fq, (u32x2){cvtpk(v[0], v[1]), cvtpk(v[2], v[3])}); }
    }
#undef ATT_ST
#undef ATT_LOAD
#undef ATT_STEP
}

__device__ __forceinline__ void attn_b_shared(const AttnP& P, int lane, int wave, LAS unsigned char* lds) {
    const int fq = lane >> 4;
    bf16x8 qf[2][2];
#pragma unroll
    for (int ks = 0; ks < 2; ++ks) { qf[0][ks] = ldg8(P.q0 + 32 * ks + 8 * fq); qf[1][ks] = ldg8(P.q1 + 32 * ks + 8 * fq); }
    f32x4 O[2][4]; float lrun[2];
#pragma unroll
    for (int g = 0; g < 2; ++g) { lrun[g] = 0.f;
#pragma unroll
        for (int dt = 0; dt < 4; ++dt) O[g][dt] = (f32x4){0.f, 0.f, 0.f, 0.f}; }
    const char* src = (const char*)(wave < 4 ? (const void*)P.K : (const void*)P.Vt) + (wave & 3) * 1024 + lane * 16;
    LAS unsigned char* dstw = lds + wave * 1024;
    const LAS unsigned char* rd = lds + lane * 16;
#define ATB_STAGE(st_, slot_) __builtin_amdgcn_global_load_lds((const unsigned*)(src + (size_t)(st_) * 4096), (LAS unsigned*)(dstw + (slot_) * 8192), 16, 0, 0)
    ATB_STAGE(0, 0); ATB_STAGE(1, 1); ATB_STAGE(2, 2);
    f32x4 sc[2][2];
    asm volatile("s_waitcnt vmcnt(2)" ::: "memory");
    __builtin_amdgcn_s_barrier();
    asm volatile("" ::: "memory");
    { bf16x8 kf[2][2]; kf[0][0] = *(const LAS bf16x8*)(rd); kf[0][1] = *(const LAS bf16x8*)(rd + 1024); kf[1][0] = *(const LAS bf16x8*)(rd + 2048); kf[1][1] = *(const LAS bf16x8*)(rd + 3072);
#pragma unroll
      for (int g = 0; g < 2; ++g)
#pragma unroll
        for (int t = 0; t < 2; ++t) { f32x4 a = (f32x4){-16.f, -16.f, -16.f, -16.f};
            a = __builtin_amdgcn_mfma_f32_16x16x32_bf16(kf[t][0], qf[g][0], a, 0, 0, 0);
            a = __builtin_amdgcn_mfma_f32_16x16x32_bf16(kf[t][1], qf[g][1], a, 0, 0, 0); sc[g][t] = a; } }
    int slot = 0;
#pragma unroll 1
    for (int s = 0; s < 72; ++s) {
        asm volatile("s_waitcnt vmcnt(1)" ::: "memory");
        __builtin_amdgcn_s_barrier();
        asm volatile("" ::: "memory");
        { const int sn = s + 3 < 72 ? s + 3 : 71; ATB_STAGE(sn, (slot + 3) & 3); }
        const LAS unsigned char* rk = rd + ((slot + 1) & 3) * 8192; const LAS unsigned char* rv = rd + slot * 8192 + 4096;
        bf16x8 kf[2][2], vf[4];
        kf[0][0] = *(const LAS bf16x8*)(rk); kf[0][1] = *(const LAS bf16x8*)(rk + 1024); kf[1][0] = *(const LAS bf16x8*)(rk + 2048); kf[1][1] = *(const LAS bf16x8*)(rk + 3072);
        vf[0] = *(const LAS bf16x8*)(rv); vf[1] = *(const LAS bf16x8*)(rv + 1024); vf[2] = *(const LAS bf16x8*)(rv + 2048); vf[3] = *(const LAS bf16x8*)(rv + 3072);
        f32x4 scn[2][2];
#pragma unroll
        for (int g = 0; g < 2; ++g)
#pragma unroll
            for (int t = 0; t < 2; ++t) { f32x4 a = (f32x4){-16.f, -16.f, -16.f, -16.f};
                a = __builtin_amdgcn_mfma_f32_16x16x32_bf16(kf[t][0], qf[g][0], a, 0, 0, 0);
                a = __builtin_amdgcn_mfma_f32_16x16x32_bf16(kf[t][1], qf[g][1], a, 0, 0, 0); scn[g][t] = a; }
        __builtin_amdgcn_sched_barrier(0);
        bf16x8 pf[2];
#pragma unroll
        for (int g = 0; g < 2; ++g) { float p[8]; float ls = 0.f;
#pragma unroll
            for (int t = 0; t < 2; ++t)
#pragma unroll
                for (int j = 0; j < 4; ++j) { p[4 * t + j] = ex2(sc[g][t][j]); ls += p[4 * t + j]; }
            lrun[g] += ls;
            const u32x4 pw = (u32x4){cvtpk(p[0], p[1]), cvtpk(p[2], p[3]), cvtpk(p[4], p[5]), cvtpk(p[6], p[7])};
            pf[g] = __builtin_bit_cast(bf16x8, pw); }
        asm volatile("s_nop 1" : "+v"(pf[0]), "+v"(pf[1]));
#pragma unroll
        for (int dt = 0; dt < 4; ++dt)
#pragma unroll
            for (int g = 0; g < 2; ++g) O[g][dt] = __builtin_amdgcn_mfma_f32_16x16x32_bf16(vf[dt], pf[g], O[g][dt], 0, 0, 0);
#pragma unroll
        for (int g = 0; g < 2; ++g)
#pragma unroll
            for (int t = 0; t < 2; ++t) sc[g][t] = scn[g][t];
        slot = (slot + 1) & 3;
    }
#undef ATB_STAGE
    asm volatile("s_waitcnt vmcnt(0)" ::: "memory");
    __builtin_amdgcn_s_barrier();
    asm volatile("" ::: "memory");
#pragma unroll
    for (int g = 0; g < 2; ++g) {
        const float l = xsum4(lrun[g]);
        const float inv = rcpf_(l); bf16* o = g == 0 ? P.o0 : P.o1;
#pragma unroll
        for (int dt = 0; dt < 4; ++dt) { const f32x4 v = O[g][dt] * inv; stg2(o + 16 * dt + 4 * fq, (u32x2){cvtpk(v[0], v[1]), cvtpk(v[2], v[3])}); }
    }
}

__device__ __forceinline__ void ssm_s12_item(Frame& F, int layer, int b, int g, int d) {
    const int fr = F.lane & 15, fq = F.lane >> 4;
    LAS float* S = (LAS float*)F.lds;
    const bf16* U = (const bf16*)(F.big + BG_UG) + (((size_t)g * 72 + b * 9) * 8) * 512 + F.lane * 8;
    const bf16* WsT = (const bf16*)(F.ws + WS_SSM + layer * SSM_LAYER + SSM_WST) + (size_t)g * 16 * 8 * 512 + F.lane * 8;
    bf16x8 bfr[8];
#pragma unroll
    for (int ks = 0; ks < 8; ++ks) bfr[ks] = ldg8(WsT + (size_t)((8 * d + F.wave) * 8 + ks) * 512);
    bf16x8 afA[8], afB[8];
#pragma unroll
    for (int ks = 0; ks < 8; ++ks) afA[ks] = ldg8(U + (size_t)ks * 512);
#define S12_TILE(cur, nxt, mt) do { if ((mt) + 1 < 9) { _Pragma("unroll") for (int ks = 0; ks < 8; ++ks) nxt[ks] = ldg8(U + (size_t)(((mt) + 1) * 8 + ks) * 512); } \
        f32x4 a = (f32x4){0.f, 0.f, 0.f, 0.f}; \
        _Pragma("unroll") for (int ks = 0; ks < 8; ++ks) a = __builtin_amdgcn_mfma_f32_16x16x32_bf16(cur[ks], bfr[ks], a, 0, 0, 0); \
        _Pragma("unroll") for (int j = 0; j < 4; ++j) S[(16 * (mt) + 4 * fq + j) * 128 + F.wave * 16 + fr] = a[j]; } while (0)
    S12_TILE(afA, afB, 0); S12_TILE(afB, afA, 1); S12_TILE(afA, afB, 2); S12_TILE(afB, afA, 3); S12_TILE(afA, afB, 4); S12_TILE(afB, afA, 5); S12_TILE(afA, afB, 6); S12_TILE(afB, afA, 7); S12_TILE(afA, afB, 8);
#undef S12_TILE
    __syncthreads();
    if (F.tid < 64) {
        const int p = F.tid;
        const f32x2 at = ((const f32x2*)(F.ws + WS_SSM + layer * SSM_LAYER + SSM_PW))[(size_t)((d * 16 + g) * 64 + p) * 17 + 16];
        GAS unsigned* hin = (GAS unsigned*)((bf16*)(F.big + BG_HIN) + ((((size_t)(b * 9) * 16 + g) * 8 + 4 * d + (p >> 4)) * 64 + ((p & 15) >> 2) * 16) * 8 + 2 * (p & 3));
        float hr = 0.f, hi = 0.f;
#pragma unroll 1
        for (int k0 = 0; k0 < NCH; k0 += 8) {
            f32x2 sv[8]; int chs[8];
#pragma unroll
            for (int q = 0; q < 8; ++q) { const int k = k0 + q; chs[q] = d == 0 ? k : (k < 16 ? 15 - k : 159 - k);
                sv[q] = *(const LAS f32x2*)(S + chs[q] * 128 + 2 * p); }
#pragma unroll
            for (int q = 0; q < 8; ++q) {
                hin[(size_t)(chs[q] >> 4) * (16 * 8 * 256) + (chs[q] & 15) * 4] = pk2(hr, hi);
                const float nr = at[0] * hr - at[1] * hi + sv[q][0], ni = at[0] * hi + at[1] * hr + sv[q][1];
                hr = nr; hi = ni;
            }
        }
    }
    __syncthreads();
}
__device__ __forceinline__ void ssm_s3_item(Frame& F, int layer, int item) {
    const int fr = F.lane & 15, fq = F.lane >> 4;
    const int ii = item & 15, ct = (item >> 4) % 9, b = item / 144;
    const int ch = 16 * ct + fr;
    const unsigned char* tb = F.ws + WS_SSM + layer * SSM_LAYER;
    const bf16* Gt = (const bf16*)(tb + SSM_G); const bf16* WgT = (const bf16*)(tb + SSM_WGT);
    const char* KcB = (const char*)(tb + SSM_KC); const char* GtB = (const char*)Gt; const char* UB = (const char*)(F.big + BG_UG); const char* HB = (const char*)(F.big + BG_HIN); const char* WB = (const char*)WgT;
    unsigned oK = (unsigned)(((ii + 15) * 16 + fr) * 32 + 16 * (fq & 1) - (fq >> 1) * 512 - 7 * 1024);
    unsigned oG = (unsigned)(ii * 8 * 1024 + F.lane * 16);
    unsigned oU = (unsigned)((size_t)(b * 9 + ct) * 8 * 1024 + F.lane * 16);
    unsigned oH = (unsigned)((size_t)(b * 9 + ct) * 16 * 8 * 1024 + F.lane * 16);
#define S3_LOAD(A_, B_, half) do { if ((half) == 0) { _Pragma("unroll") for (int ks = 0; ks < 8; ++ks) { A_[ks] = ldg8(KcB + oK + (7 - ks) * 1024); B_[ks] = ldg8(UB + oU + 1024 * ks); } } \
        else { _Pragma("unroll") for (int ks = 0; ks < 8; ++ks) { A_[ks] = ldg8(GtB + oG + 1024 * ks); B_[ks] = ldg8(HB + oH + 1024 * ks); } } } while (0)
#define S3_ADV() do { oK += 31 * 512; oG += 131072; oU += NT * 32; oH += 8192; asm volatile("" : "+v"(oK), "+v"(oG), "+v"(oU), "+v"(oH)); } while (0)
    bf16x8 zb[8];
    bf16x8 a0[8], b0[8], a1[8], b1[8];
    asm volatile("" : "+v"(oK), "+v"(oG), "+v"(oU), "+v"(oH));
    S3_LOAD(a0, b0, 0);
#pragma unroll
    for (int kap = 0; kap < 8; ++kap) {
        float zz[2][4];
#pragma unroll
        for (int gg = 0; gg < 2; ++gg) {
            f32x4 a = (f32x4){0.f, 0.f, 0.f, 0.f};
            S3_LOAD(a1, b1, 1);
            __builtin_amdgcn_sched_barrier(0);
#pragma unroll
            for (int ks = 0; ks < 8; ++ks) a = __builtin_amdgcn_mfma_f32_16x16x32_bf16(a0[ks], b0[ks], a, 0, 0, 0);
            __builtin_amdgcn_sched_barrier(0);
            S3_ADV();
            if (kap * 2 + gg < 15) S3_LOAD(a0, b0, 0);
            __builtin_amdgcn_sched_barrier(0);
#pragma unroll
            for (int ks = 0; ks < 8; ++ks) a = __builtin_amdgcn_mfma_f32_16x16x32_bf16(a1[ks], b1[ks], a, 0, 0, 0);
#pragma unroll
            for (int j = 0; j < 4; ++j) zz[gg][j] = gelu_tanh(a[j]);
            __builtin_amdgcn_sched_barrier(0);
        }
        const u32x4 w = (u32x4){cvtpk(zz[0][0], zz[0][1]), cvtpk(zz[0][2], zz[0][3]), cvtpk(zz[1][0], zz[1][1]), cvtpk(zz[1][2], zz[1][3])};
        zb[kap] = __builtin_bit_cast(bf16x8, w); asm volatile("s_nop 1" : "+v"(zb[kap]));
    }
#undef S3_LOAD
#undef S3_ADV
    const int t = 16 * ch + ii;
    bf16* orow = (bf16*)(F.big + BG_MIX) + ((size_t)b * TPB + t) * 1024 + 512;
    unsigned oW = (unsigned)(F.lane * 16);
    asm volatile("" : "+v"(oW));
#pragma unroll
    for (int kap = 0; kap < 8; ++kap) a0[kap] = ldg8(WB + oW + 1024 * kap);
#pragma unroll
    for (int mu = 0; mu < 16; ++mu) {
        oW += 8192; asm volatile("" : "+v"(oW));
        if (mu < 15) {
            if (mu & 1) {
#pragma unroll
                for (int kap = 0; kap < 8; ++kap) a0[kap] = ldg8(WB + oW + 1024 * kap);
            } else {
#pragma unroll
                for (int kap = 0; kap < 8; ++kap) a1[kap] = ldg8(WB + oW + 1024 * kap);
            }
        }
        __builtin_amdgcn_sched_barrier(0);
        f32x4 a = (f32x4){0.f, 0.f, 0.f, 0.f};
#pragma unroll
        for (int kap = 0; kap < 8; ++kap) a = __builtin_amdgcn_mfma_f32_16x16x32_bf16((mu & 1) ? a1[kap] : a0[kap], zb[kap], a, 0, 0, 0);
        const u32x4 zw = __builtin_bit_cast(u32x4, zb[mu >> 1]);
        const unsigned z01 = (mu & 1) ? zw.z : zw.x, z23 = (mu & 1) ? zw.w : zw.y;
        const float o0 = bf2f(z01 & 0xffffu) * sigmoidf_(a[0]), o1 = bf2f(z01 >> 16) * sigmoidf_(a[1]), o2 = bf2f(z23 & 0xffffu) * sigmoidf_(a[2]), o3 = bf2f(z23 >> 16) * sigmoidf_(a[3]);
        stg2(orow + 16 * mu + 4 * fq, (u32x2){cvtpk(o0, o1), cvtpk(o2, o3)});
        __builtin_amdgcn_sched_barrier(0);
    }
}

__device__ __forceinline__ void phase_m1(Frame& F, int layer, int parts) {
    LAS float* rpbl = (LAS float*)(F.lds + RING_BYTES);
    if (parts & 4) { const float* rp = F.in[I_RPB] + (size_t)layer * 4 * 465; for (int i = F.tid; i < 4 * 465; i += 512) rpbl[i] = rp[i] * LOG2E; }
    __syncthreads();
    if (parts & 1) for (int it = F.vcu; it < NB * 32; it += F.G) ssm_s12_item(F, layer, it >> 5, (it >> 1) & 15, it & 1);
    const int fr = F.lane & 15;
    if (parts & 2) for (int it = F.gw; it < NB * 2 * 128; it += F.NGW) {
        const int jg = it & 127, kvh = (it >> 7) & 1, b = it >> 8;
        const size_t row = (size_t)b * TPB + 256 + 16 * jg + fr;
        AttnP P; P.q0 = (const bf16*)(F.big + BG_QB) + row * 256 + (2 * kvh) * 64; P.q1 = P.q0 + 64;
        P.K = (const bf16*)(F.big + BG_KB) + (size_t)(b * 2 + kvh) * 64 * TPB; P.kstride = 128;
        P.Vt = (const bf16*)(F.big + BG_VBT) + (size_t)(b * 2 + kvh) * 64 * TPB;
        P.o0 = (bf16*)(F.big + BG_MIX) + row * 1024 + 256 + (2 * kvh) * 64; P.o1 = P.o0 + 64;
        P.nfull = 72; P.has_sink = 0; P.sink0 = P.sink1 = 0.f; P.jg = jg; P.r = 0; P.g4 = 0; P.rpb = nullptr;
        if (F.G == 256) attn_b_shared(P, F.lane, F.wave, F.lds); else attn_item<2, 3>(P, F.lane);
    }
    if (parts & 4) for (int k2 = 0, it = (F.G == 256) ? ((F.vcu >> 5) << 9) | ((F.vcu & 31) * 8 + F.wave) : F.gw; it < NB * 4 * 32 * 4 && (F.G != 256 || k2 < 2); ++k2, it += (F.G == 256) ? 256 : F.NGW) {
        const int g4 = it & 3, r = (it >> 2) & 31, h = (it >> 7) & 3, b = it >> 9;
        const size_t row = (size_t)b * TPB + 256 + 64 * r + 16 * g4 + fr;
        AttnP P; P.q0 = (const bf16*)(F.big + BG_QA) + row * 256 + h * 64; P.q1 = P.q0;
        P.K = (const bf16*)(F.big + BG_KA) + (size_t)(b * 4 + h) * 64 * TPB; P.kstride = 256;
        P.Vt = (const bf16*)(F.big + BG_VAT) + (size_t)(b * 4 + h) * 64 * TPB;
        P.o0 = (bf16*)(F.big + BG_MIX) + row * 1024 + h * 64; P.o1 = P.o0;
        P.nfull = 8; P.has_sink = 0; P.sink0 = P.sink1 = 0.f; P.jg = 0; P.r = r; P.g4 = g4; P.rpb = rpbl + h * 465;
        attn_item<1, 2>(P, F.lane);
    }
}
__device__ __forceinline__ void phase_m2(Frame& F, int layer, int M2P) {
    const int fr = F.lane & 15;
    const bool need_ctx = layer < DEPTH - 1;
    const float* sink = F.in[I_SINK] + layer * 4; const float* rpb_l = F.in[I_RPB] + (size_t)layer * 4 * 15 * 31;
#define M2_PARTS M2P
    if (M2_PARTS & 1) for (int it = F.gw; it < NB * 2 * 128; it += F.NGW) {
        const int jg = it & 127, kvh = (it >> 7) & 1, b = it >> 8;
        const size_t row = (size_t)b * TPB + 256 + 16 * jg + fr;
        AttnP P; P.q0 = (const bf16*)(F.big + BG_QD) + row * 256 + (2 * kvh) * 64; P.q1 = P.q0 + 64;
        P.K = (const bf16*)(F.big + BG_KD) + (size_t)(b * 2 + kvh) * 64 * TPB; P.kstride = 128;
        P.Vt = (const bf16*)(F.big + BG_VDT) + (size_t)(b * 2 + kvh) * 64 * TPB;
        P.o0 = (bf16*)(F.big + BG_MIX) + row * 1024 + 768 + (2 * kvh) * 64; P.o1 = P.o0 + 64;
        P.nfull = 8; P.has_sink = 1; P.sink0 = sink[2 * kvh]; P.sink1 = sink[2 * kvh + 1]; P.jg = jg; P.r = 0; P.g4 = 0; P.rpb = nullptr;
        attn_item<2, 1>(P, F.lane);
    }
    const bool xl = (F.G == 256);
    const int li = F.wave * 32 + (F.vcu & 31), xb = F.vcu >> 5;
    const int gwp = F.wave * F.G + (int)blockIdx.x;
    if (M2_PARTS & 4) { if (xl) { if (li < 144) ssm_s3_item(F, layer, xb * 144 + li); } else for (int it = gwp; it < NB * 9 * 16; it += F.NGW) ssm_s3_item(F, layer, it); }
    const int cl = xl ? ((li + 256 - 144) & 255) : 0;
    if (need_ctx) {
        if (M2_PARTS & 8) for (int it = xl ? (cl < 64 ? ((cl >> 5) << 8) | (xb << 5) | (cl & 31) : 1 << 30) : (gwp + 896) % F.NGW; it < 2 * NB * 2 * 16; it += F.NGW) {
            const int jq = it & 15, kvh = (it >> 4) & 1, b = (it >> 5) & 7, which = it >> 8;
            const size_t row = (size_t)b * TPB + 16 * jq + fr;
            AttnP P; P.q0 = (const bf16*)(F.big + (which ? BG_QD : BG_QB)) + row * 256 + (2 * kvh) * 64; P.q1 = P.q0 + 64;
            P.K = (const bf16*)(F.big + (which ? BG_KD : BG_KB)) + (size_t)(b * 2 + kvh) * 64 * TPB; P.kstride = 128;
            P.Vt = (const bf16*)(F.big + (which ? BG_VDT : BG_VBT)) + (size_t)(b * 2 + kvh) * 64 * TPB;
            P.o0 = (bf16*)(F.big + BG_MIX) + row * 1024 + (which ? 768 : 256) + (2 * kvh) * 64; P.o1 = P.o0 + 64;
            P.nfull = 8; P.has_sink = which; P.sink0 = sink[2 * kvh]; P.sink1 = sink[2 * kvh + 1]; P.jg = 0; P.r = 0; P.g4 = 0; P.rpb = nullptr;
            attn_item<2, 0>(P, F.lane);
        }
        if (M2_PARTS & 16) for (int it = xl ? (cl >= 64 && cl < 128 ? xb * 64 + (cl - 64) : 1 << 30) : (gwp + 384) % F.NGW; it < NB * 4 * 16; it += F.NGW) {
            const int jq = it & 15, h = (it >> 4) & 3, b = it >> 6;
            const size_t row = (size_t)b * TPB + 16 * jq + fr;
            AttnP P; P.q0 = (const bf16*)(F.big + BG_QA) + row * 256 + h * 64; P.q1 = P.q0;
            P.K = (const bf16*)(F.big + BG_KA) + (size_t)(b * 4 + h) * 64 * TPB; P.kstride = 256;
            P.Vt = (const bf16*)(F.big + BG_VAT) + (size_t)(b * 4 + h) * 64 * TPB;
            P.o0 = (bf16*)(F.big + BG_MIX) + row * 1024 + h * 64; P.o1 = P.o0;
            P.nfull = 8; P.has_sink = 0; P.sink0 = P.sink1 = 0.f; P.jg = 0; P.r = 0; P.g4 = 0; P.rpb = nullptr;
            attn_item<1, 0>(P, F.lane);
        }
    }
}

constexpr int N_PHASES = 2 + 8 * DEPTH;
template <bool ONE>
__global__ void __launch_bounds__(NWAVES * 64, 2) fwd_kernel(Args args) {
    extern __shared__ __attribute__((aligned(16))) unsigned char lds_raw[];
    Frame F;
    F.lds = (LAS unsigned char*)lds_raw;
    F.tid = threadIdx.x; F.lane = F.tid & 63; F.wave = __builtin_amdgcn_readfirstlane(F.tid >> 6);
    F.G = gridDim.x; { const int bx = blockIdx.x; F.vcu = (F.G % 8 == 0) ? (bx % 8) * (F.G / 8) + bx / 8 : bx; }
    F.gw = F.vcu * NWAVES + F.wave; F.NGW = F.G * NWAVES;
    F.in.t = (const LAS unsigned long long*)(F.lds + MISC_OFF + 256); F.out = args.out;
    volatile LAS unsigned* MISC = (volatile LAS unsigned*)(F.lds + MISC_OFF);
    if (F.tid < 64) MISC[F.tid] = 0u;
    if (F.tid == 64) { LAS unsigned long long* tb = (LAS unsigned long long*)(F.lds + MISC_OFF + 256);
#pragma unroll
        for (int i = 0; i < 33; ++i) tb[i] = (unsigned long long)args.in[i]; }
    __syncthreads();
    const int lo = ONE ? 0 : args.ph_lo, hi = ONE ? N_PHASES : args.ph_hi;
    const bool one_launch = ONE;
    XcdBarrier bar; bar.bar = (unsigned*)(args.ws + WS_CTL) + CW_BAR; bar.x = 0; bar.st = MISC + 8;
    if (one_launch) { bar = xcd_barrier_post((unsigned*)(args.ws + WS_CTL) + CW_BAR, MISC + 8);
        if (F.tid == 0) atomicOr((unsigned*)(args.ws + WS_CTL) + CW_XMASK + 64 * (F.vcu >> 5 & 7), 1u << bar.x); }
#ifdef ONLY_MASK
#define IN(k) (((ONLY_MASK >> (((k) < 2) ? (k) : 2 + (((k) - 2) & 7))) & 1) && lo <= (k) && (k) < hi)
#elif defined(ONLY_PHASE)
#define IN(k) ((((k) < 2) ? (k) : 2 + (((k) - 2) & 7)) == ONLY_PHASE && lo <= (k) && (k) < hi)
#else
#define IN(k) (lo <= (k) && (k) < hi)
#endif
#define LAUNDER() do { unsigned _m = ~0u; unsigned char* _w = args.ws; unsigned _lo = MISC_OFF + 256; asm volatile("" : "+s"(_m), "+s"(_w), "+s"(_lo) :: "memory"); \
      \
    int _t = F.wave * 64 + (int)__builtin_amdgcn_mbcnt_hi(_m, __builtin_amdgcn_mbcnt_lo(_m, 0u)); asm volatile("" : "+v"(_t)); F.tid = _t; F.lane = _t & 63; F.ws = _w; \
    F.in.t = (const LAS unsigned long long*)(F.lds + _lo); \
    F.ctl = (unsigned*)(_w + WS_CTL); F.mods = (float*)(_w + WS_MODS); F.rope = (float*)(_w + WS_ROPE); F.H = (float*)(_w + WS_H); F.Y = (float*)(_w + WS_Y); F.ABF = (bf16*)(_w + WS_ABF); F.big = _w + WS_BIG; } while (0)
#define REP(kind) for (int _r = 0; _r < (((REP_MASK) >> (kind)) & 1) + 1; ++_r)
#define REPC(kind, cond) for (int _r = 0; _r < ((((REP_MASK) >> (kind)) & 1) && (cond) ? 2 : 1); ++_r)
#define SEAM(k) do { if (IN((k) + 1)) { XcdBarrier _b = bar; _b.bar = (unsigned*)(args.ws + WS_CTL) + CW_BAR; asm volatile("" : "+s"(_b.bar)); xcd_barrier(_b); } else { VM_WAIT(); __syncthreads(); } } while (0)
#define SEAM_L(k) do { if (one_launch && __builtin_amdgcn_readfirstlane(MISC[11]) != 0u) { if (IN((k) + 1)) { unsigned* _c = (unsigned*)(args.ws + WS_CTL); asm volatile("" : "+s"(_c)); \
        group_barrier(_c + CW_BAR, _c + CW_LBAR + 64 * (F.vcu >> 5 & 7), MISC + 10); } } else SEAM(k); } while (0)
    if (IN(0)) REP(0) { LAUNDER(); phase_p0a(F); SEAM(0);
        if (one_launch) {
            if (F.tid == 0) { const unsigned* xm = (const unsigned*)(args.ws + WS_CTL) + CW_XMASK; bool ok = (gridDim.x == 256);
                for (int g = 0; g < 8; ++g) { const unsigned m = __hip_atomic_load(xm + 64 * g, __ATOMIC_RELAXED, __HIP_MEMORY_SCOPE_AGENT); ok = ok && m != 0u && (m & (m - 1u)) == 0u; }
                MISC[11] = ok ? 1u : 0u; }
            __syncthreads(); } }
    if (IN(1)) REP(1) { LAUNDER(); phase_p0b(F); SEAM(1); }
#pragma unroll 1
    for (int layer = 0; layer < DEPTH; ++layer) {
        const int pb = 2 + 8 * layer;
        const bool moe = (layer & 1) != 0, last = (layer == DEPTH - 1);
        if (IN(pb + 0)) REP(2) { LAUNDER();
            pg8::Sched S; S.init(72, 8, F.G, (int)blockIdx.x, 0);
            EpiInProj E{F.big, F.in[I_GQ] + layer * 64, F.in[I_GK] + layer * 64, F.rope};
            pg8::gemm_phase<EpiInProj, false, false>(F.tid, F.lds, F.ABF, (const bf16*)(F.ws + WS_WIN) + (size_t)layer * 2048 * 1024, 2048, 0, S, E);
            convert_grab(F, tail_quota(S.nwg, F.G, (int)blockIdx.x, 1), 0);
            SEAM_L(pb + 0);
        }
        if (IN(pb + 1)) REP(3) { LAUNDER(); phase_m1(F, layer, _r == 0 ? 7 : PROBE_PARTS); SEAM_L(pb + 1); }
        if (IN(pb + 2)) REP(4) { LAUNDER(); phase_m2(F, layer, _r == 0 ? 31 : PROBE_PARTS); SEAM_L(pb + 2); }
        if (IN(pb + 3)) REPC(5, layer == 0) { LAUNDER();
            pg8::Sched S; S.init(last ? 64 : 72, 4, F.G, (int)blockIdx.x, last ? 1 : 0);
            EpiResid E{layer > 0 ? F.H : F.in[I_X], F.Y, F.mods + (size_t)layer * 9 * 6144, 2, layer > 0 ? 1 : 0, layer > 0 ? F.in[I_LN2G] + (layer - 1) * 1024 : F.in[I_CTX], F.in[I_LN2B] + (layer > 0 ? layer - 1 : 0) * 1024, (const float*)(F.ws + WS_STATS) + 2 * NT, 1.0f};
            pg8::gemm_phase<EpiResid, false, false>(F.tid, F.lds, (const bf16*)(F.big + BG_MIX), (const bf16*)(F.ws + WS_WOUT) + (size_t)layer * 1024 * 1024, 2048, 0, S, E);
            convert_grab(F, tail_quota(S.nwg, F.G, (int)blockIdx.x, 2), 0);
            SEAM_L(pb + 3);
        }
        if (IN(pb + 4)) REPC(6, !moe) { LAUNDER(); if (moe) { phase_ln1<true>(F, layer); SEAM(pb + 4); } else { phase_ln1<false>(F, layer); SEAM_L(pb + 4); } }
        const bool gu8 = moe || ((F8GU_MASK >> (layer >> 1)) & 1) != 0;
        if (IN(pb + 5) && !gu8) REP(7) { LAUNDER();
            LAS int* lc = (LAS int*)(F.lds + MISC_OFF + 128);
            if (F.tid < 8) lc[F.tid] = (F.tid == 0 ? NT : 0);
            __syncthreads();
            pg8::Sched S; S.init_cnt(lc, (const int*)(F.ws + WS_IDLIST), 22, F.G, (int)blockIdx.x);
            EpiSwiglu<true> E{(void*)F.H, DFF, 1.0f};
            pg8::gemm_phase<EpiSwiglu<true>, true, false>(F.tid, F.lds, F.ABF, (const bf16*)(F.ws + WS_WFGU) + (size_t)(layer >> 1) * 5632 * 1024, 2048, 0, S, E);
            convert_grab(F, tail_quota(S.nwg, F.G, (int)blockIdx.x, 1), 0);
            SEAM_L(pb + 5);
        }
        if (IN(pb + 5) && gu8) REP(10) { LAUNDER();
            LAS int* lc = (LAS int*)(F.lds + MISC_OFF + 128);
            if (F.tid < 8) lc[F.tid] = moe ? (int)__hip_atomic_load(F.ctl + CW_CNT + (layer >> 1) * 64 + F.tid, __ATOMIC_RELAXED, __HIP_MEMORY_SCOPE_AGENT) : (F.tid == 0 ? NT : 0);
            __syncthreads();
            pg8::Sched S; S.init_cnt(lc, (const int*)(F.ws + (moe ? WS_LIST : WS_IDLIST)), moe ? 28 : 22, F.G, (int)blockIdx.x);
            EpiSwiglu<true> E{moe ? (void*)F.big : (void*)F.H, moe ? DFE : DFF, 1.0f / 2048.0f};
            pg8::gemm_phase<EpiSwiglu<true>, true, true>(F.tid, F.lds, F.ABF, moe ? F.ws + WS_WMGU + (size_t)(layer >> 1) * 8 * 7168 * 1024 : F.ws + WS_WFGU + (size_t)(layer >> 1) * 5632 * 1024 * 2, 1024, moe ? (size_t)7168 * 1024 : (size_t)0, S, E);
            convert_grab(F, tail_quota(S.nwg, F.G, (int)blockIdx.x, 1), 0);
            if (moe) SEAM(pb + 5); else SEAM_L(pb + 5);
        }
        if (IN(pb + 6)) REPC(8, moe) { LAUNDER();
            if (!moe) {
                pg8::Sched S; S.init(72, 4, F.G, (int)blockIdx.x, 0);
                EpiResid E{F.H, F.Y, F.mods + (size_t)layer * 9 * 6144, 5, 1, F.in[I_LN1G] + layer * 1024, F.in[I_LN1B] + layer * 1024, (const float*)(F.ws + WS_STATS), 1.0f / 4096.0f};
                pg8::gemm_phase<EpiResid, false, true>(F.tid, F.lds, F.H, F.ws + WS_WFD + (size_t)(layer >> 1) * 1024 * DFF, DFF, 0, S, E);
                convert_grab(F, tail_quota(S.nwg, F.G, (int)blockIdx.x, 4), 0);
                SEAM_L(pb + 6);
            } else {
                LAS int* lc = (LAS int*)(F.lds + MISC_OFF + 128);
                if (F.tid < 8) lc[F.tid] = (int)__hip_atomic_load(F.ctl + CW_CNT + (layer >> 1) * 64 + F.tid, __ATOMIC_RELAXED, __HIP_MEMORY_SCOPE_AGENT);
                __syncthreads();
                pg8::Sched S; S.init_cnt(lc, (const int*)(F.ws + WS_LIST), 4, F.G, (int)blockIdx.x);
                EpiBf16Out E{(bf16*)(F.ws + WS_MOUT), 1.0f / 4096.0f};
                pg8::gemm_phase<EpiBf16Out, false, true>(F.tid, F.lds, F.big, F.ws + WS_WMD + (size_t)(layer >> 1) * 8 * 1024 * DFE, DFE, (size_t)1024 * DFE, S, E);
                convert_grab(F, tail_quota(S.nwg, F.G, (int)blockIdx.x, 3), 0);
                SEAM(pb + 6);
            }
        }
        if (IN(pb + 7)) REPC(9, !moe) { LAUNDER(); phase_ln2(F, layer); if (!last) SEAM_L(pb + 7); }
    }
#undef IN
#undef SEAM
#undef SEAM_L
#undef LAUNDER
#undef REP
#undef REPC
}

extern "C" void kernel_launch(void* const* d_in, const int* in_sizes, int n_in, void* d_out, int out_size, void* d_ws, size_t ws_size, hipStream_t stream) {
    static int grid = 0;
    if (grid == 0) {
        if (n_in != 33 || out_size != NB * SEQ * D || ws_size < WS_END) { fprintf(stderr, "kernel_launch: unexpected problem (n_in %d, out %d, ws %zu < %zu)\n", n_in, out_size, ws_size, (size_t)WS_END); grid = -1; return; }
        int dev = 0, cus = 0, per_cu = 0;
        if (hipGetDevice(&dev) != hipSuccess || hipDeviceGetAttribute(&cus, hipDeviceAttributeMultiprocessorCount, dev) != hipSuccess) { grid = -1; return; }
        if (hipFuncSetAttribute((const void*)fwd_kernel<!MK_MULTI>, hipFuncAttributeMaxDynamicSharedMemorySize, LDS_BYTES) != hipSuccess) { fprintf(stderr, "kernel_launch: hipFuncSetAttribute failed\n"); grid = -1; return; }
        if (hipOccupancyMaxActiveBlocksPerMultiprocessor(&per_cu, (const void*)fwd_kernel<!MK_MULTI>, NWAVES * 64, LDS_BYTES) != hipSuccess || per_cu < 1) { fprintf(stderr, "kernel_launch: occupancy query says %d\n", per_cu); }
        (void)hipGetLastError();
        grid = cus;
    }
    if (grid < 0) return;
    if (hipMemsetAsync((char*)d_ws + WS_CTL, 0, CTL_BYTES, stream) != hipSuccess) return;
    Args a{};
    for (int i = 0; i < 33; ++i) a.in[i] = (const float*)d_in[i];
    a.out = (float*)d_out; a.ws = (unsigned char*)d_ws;
#if MK_MULTI
    for (int p = 0; p < N_PHASES; ++p) { a.ph_lo = p; a.ph_hi = p + 1; hipLaunchKernelGGL(fwd_kernel<!MK_MULTI>, dim3(grid), dim3(NWAVES * 64), LDS_BYTES, stream, a); }
#else
    a.ph_lo = 0; a.ph_hi = N_PHASES;
    hipLaunchKernelGGL(fwd_kernel<!MK_MULTI>, dim3(grid), dim3(NWAVES * 64), LDS_BYTES, stream, a);
#endif
}
```

```cpp
#include <hip/hip_runtime.h>
#include <stdint.h>
#include <stdio.h>

#ifndef REP_MASK
#define REP_MASK 0
#endif
#ifndef PROBE_PARTS
#define PROBE_PARTS 31
#endif
#ifndef F8GU_MASK
#define F8GU_MASK 3
#endif
#ifndef MK_MULTI
#define MK_MULTI 0
#endif

#define GAS __attribute__((address_space(1)))
#define LAS __attribute__((address_space(3)))
typedef unsigned short bf16;
typedef short bf16x8 __attribute__((ext_vector_type(8)));
typedef float f32x4 __attribute__((ext_vector_type(4)));
typedef float f32x2 __attribute__((ext_vector_type(2)));
typedef unsigned u32x4 __attribute__((ext_vector_type(4)));
typedef unsigned u32x2 __attribute__((ext_vector_type(2)));
typedef int i32x4 __attribute__((ext_vector_type(4)));
typedef int i32x8 __attribute__((ext_vector_type(8)));

constexpr int D = 1024, NB = 8, SEQ = 2048, CTXL = 256, TPB = 2304, NT = NB * TPB;
constexpr int INW = 2048, DFF = 2816, NE = 8, DFE = 3584, DEPTH = 4;
constexpr int NCH = TPB / 16;
constexpr float ALPHA = 1.681792830507429f;
constexpr float LOG2E = 1.4426950408889634f;
constexpr float QSCALE = 0.125f * LOG2E;
constexpr int MAXROWS = 2 * NT + NE * 256;

constexpr size_t MiB = 1u << 20;
constexpr size_t WS_CTL = 0, CTL_BYTES = 2 * MiB;
constexpr size_t WS_MODS = 1 * MiB;
constexpr size_t WS_ROPE = 2 * MiB;
constexpr size_t WS_SSM = 3 * MiB, SSM_LAYER = 5 * MiB;
constexpr size_t SSM_WST = 0, SSM_FF = 2 * MiB, SSM_KC = 2 * MiB + 65536, SSM_G = 2 * MiB + 65536 + 262144, SSM_WGT = SSM_G + 2 * MiB, SSM_PW = SSM_WGT + 131072;
static_assert(SSM_PW + 2 * 16 * 64 * 17 * 8 <= SSM_LAYER, "ssm tables");
constexpr size_t WS_TOKINFO = 23 * MiB;
constexpr size_t WS_STATS = 23 * MiB + 640 * 1024;
constexpr size_t WS_MOUT = 196 * MiB;
constexpr size_t WS_LIST = 24 * MiB;
constexpr size_t WS_IDLIST = 25 * MiB;
constexpr size_t WS_WIN = 26 * MiB;
constexpr size_t WS_WOUT = 42 * MiB;
constexpr size_t WS_WFGU = 50 * MiB;
constexpr size_t WS_WFD = 72 * MiB;
constexpr size_t WS_WMGU = 84 * MiB;
constexpr size_t WS_WMD = 308 * MiB;
constexpr size_t WS_H = 420 * MiB;
constexpr size_t WS_Y = 492 * MiB;
constexpr size_t WS_ABF = 568 * MiB;
constexpr size_t WS_BIG = 604 * MiB;
constexpr size_t WS_KX = 870 * MiB;
constexpr size_t WS_END = 878 * MiB;
constexpr size_t BG_QA = 0, BG_KA = 9 * MiB, BG_VAT = 18 * MiB, BG_QB = 28 * MiB, BG_KB = 37 * MiB, BG_VBT = 42 * MiB, BG_UG = 48 * MiB,
                 BG_QD = 57 * MiB, BG_KD = 66 * MiB, BG_VDT = 71 * MiB, BG_MIX = 77 * MiB, BG_HIN = 113 * MiB, BG_END = 123 * MiB;
static_assert((size_t)MAXROWS * DFE * 2 <= WS_END - WS_BIG && BG_END <= WS_END - WS_BIG, "big region");
constexpr int CW_BAR = 4096;
constexpr int CW_CNT = 16384;
constexpr int CW_LBAR = 24576;
constexpr int CW_XMASK = 28672;
constexpr int CW_Q = 20480;
constexpr int Q_PER = 3 * 112, Q_TOTAL = 16 * Q_PER;

__device__ __forceinline__ unsigned f2bf(float f) { unsigned u = __builtin_bit_cast(unsigned, f); return (u + 0x7fffu + ((u >> 16) & 1u)) >> 16; }
__device__ __forceinline__ unsigned pk2(float lo, float hi) { unsigned r; asm volatile("v_cvt_pk_bf16_f32 %0, %1, %2" : "=v"(r) : "v"(lo), "v"(hi)); return r; }
__device__ __forceinline__ float bf2f(unsigned v) { return __builtin_bit_cast(float, v << 16); }
__device__ __forceinline__ float ex2(float x) { return __builtin_amdgcn_exp2f(x); }
__device__ __forceinline__ float rcpf_(float x) { return __builtin_amdgcn_rcpf(x); }
__device__ __forceinline__ float sigmoidf_(float x) { return rcpf_(1.0f + ex2(-x * LOG2E)); }
__device__ __forceinline__ float siluf_(float x) { return x * sigmoidf_(x); }
__device__ __forceinline__ float gelu_tanh(float x) { const float u = 0.7978845608028654f * (x + 0.044715f * x * x * x); const float t = 1.0f - 2.0f * rcpf_(ex2(2.0f * u * LOG2E) + 1.0f); return 0.5f * x * (1.0f + t); }
__device__ __forceinline__ unsigned cvtpk(float lo, float hi) { unsigned r; asm volatile("v_cvt_pk_bf16_f32 %0, %1, %2" : "=v"(r) : "v"(lo), "v"(hi)); return r; }
__device__ __forceinline__ bf16x8 ldg8(const void* p) { return *(const GAS bf16x8*)p; }
__device__ __forceinline__ void stg2(void* p, u32x2 v) { *(GAS u32x2*)p = v; }
__device__ __forceinline__ void stg4(void* p, u32x4 v) { *(GAS u32x4*)p = v; }
__device__ __forceinline__ f32x4 ldgf4(const void* p) { return *(const GAS f32x4*)p; }
__device__ __forceinline__ void stgf4(void* p, f32x4 v) { *(GAS f32x4*)p = v; }
__device__ __forceinline__ u32x2 ldg2(const void* p) { return *(const GAS u32x2*)p; }
__device__ __forceinline__ f32x4 ldgf4_nt(const void* p) { return __builtin_nontemporal_load((const GAS f32x4*)p); }
__device__ __forceinline__ void stg4_nt(void* p, u32x4 v) { __builtin_nontemporal_store(v, (GAS u32x4*)p); }
__device__ __forceinline__ float clamp8(float x) { return __builtin_fminf(__builtin_fmaxf(x, -448.0f), 448.0f); }
__device__ __forceinline__ unsigned pk4_fp8(float a, float b, float c, float d) { int w = __builtin_amdgcn_cvt_pk_fp8_f32(clamp8(a), clamp8(b), 0, false); w = __builtin_amdgcn_cvt_pk_fp8_f32(clamp8(c), clamp8(d), w, true); return (unsigned)w; }
__device__ __forceinline__ float u2f(unsigned u) { return __builtin_bit_cast(float, u); }
#define LDS_WAIT() asm volatile("s_waitcnt lgkmcnt(0)" ::: "memory")
#define VM_WAIT() asm volatile("s_waitcnt vmcnt(0)" ::: "memory")
__device__ __forceinline__ float xmax4(float x) {
    const unsigned xi = __builtin_bit_cast(unsigned, x);
    const u32x2 r = __builtin_amdgcn_permlane16_swap(xi, xi, false, false);
    const unsigned r0 = r[0], r1 = r[1];
    const float m = fmaxf(u2f(r0), u2f(r1));
    const unsigned mi = __builtin_bit_cast(unsigned, m);
    const u32x2 q = __builtin_amdgcn_permlane32_swap(mi, mi, false, false);
    const unsigned q0 = q[0], q1 = q[1];
    return fmaxf(u2f(q0), u2f(q1));
}
__device__ __forceinline__ float xsum4(float x) {
    const unsigned xi = __builtin_bit_cast(unsigned, x);
    const u32x2 r = __builtin_amdgcn_permlane16_swap(xi, xi, false, false);
    const unsigned r0 = r[0], r1 = r[1];
    const float m = u2f(r0) + u2f(r1);
    const unsigned mi = __builtin_bit_cast(unsigned, m);
    const u32x2 q = __builtin_amdgcn_permlane32_swap(mi, mi, false, false);
    const unsigned q0 = q[0], q1 = q[1];
    return u2f(q0) + u2f(q1);
}
template <int CTRL> __device__ __forceinline__ float dpp_mov(float x) { return __builtin_bit_cast(float, __builtin_amdgcn_mov_dpp(__builtin_bit_cast(int, x), CTRL, 0xf, 0xf, true)); }
__device__ __forceinline__ float wave_sum(float v) {
    v += dpp_mov<0xB1>(v);
    v += dpp_mov<0x4E>(v);
    v += dpp_mov<0x141>(v);
    v += dpp_mov<0x140>(v);
    return xsum4(v);
}
__device__ __forceinline__ void sincos_d(double x, double& s, double& c) {
    const double k = __builtin_rint(x * 0.6366197723675814);
    double r = __builtin_fma(-k, 1.5707963267948966, x);
    r = __builtin_fma(-k, 6.123233995736766e-17, r);
    const double r2 = r * r;
    const double sp = r * (1.0 + r2 * (-1.0 / 6 + r2 * (1.0 / 120 + r2 * (-1.0 / 5040 + r2 * (1.0 / 362880 + r2 * (-1.0 / 39916800 + r2 * (1.0 / 6227020800.0 + r2 * (-1.0 / 1307674368000.0))))))));
    const double cp = 1.0 + r2 * (-0.5 + r2 * (1.0 / 24 + r2 * (-1.0 / 720 + r2 * (1.0 / 40320 + r2 * (-1.0 / 3628800 + r2 * (1.0 / 479001600.0 + r2 * (-1.0 / 87178291200.0 + r2 * (1.0 / 20922789888000.0))))))));
    const int q = ((int)k) & 3;
    s = q == 0 ? sp : q == 1 ? cp : q == 2 ? -sp : -cp;
    c = q == 0 ? cp : q == 1 ? -sp : q == 2 ? -cp : sp;
}

#define XB_TMO      128
#define XB_XCNT(j)  (256  + 64 * (j))
#define XB_XSUB(j)  (1280 + 64 * (j))
#define XB_XGEN(j)  (2304 + 64 * (j))
#define XB_TOP      3328
#define XB_TOPGEN   3392
#define XCD_BAR_WORDS 3456
#define XB_SPIN_CAP (1u << 18)
__device__ __forceinline__ unsigned xb_ld(unsigned* p)              { return __hip_atomic_load(p, __ATOMIC_RELAXED, __HIP_MEMORY_SCOPE_AGENT); }
__device__ __forceinline__ unsigned xb_add(unsigned* p, unsigned v) { return __hip_atomic_fetch_add(p, v, __ATOMIC_RELAXED, __HIP_MEMORY_SCOPE_AGENT); }
__device__ __forceinline__ unsigned xb_xcc_id() { return (unsigned)__builtin_amdgcn_s_getreg((3 << 11) | 20) & 0xFu; }
#define XB_SPIN(cond, bar) do { unsigned _sp = 0; while (cond) { __builtin_amdgcn_s_sleep(1); \
    if ((++_sp & 255u) == 0u) { if (xb_ld(&(bar)[XB_TMO])) break; if (_sp > XB_SPIN_CAP) { atomicAdd(&(bar)[XB_TMO], 1u); break; } } } } while (0)
struct XcdBarrier { unsigned* bar; unsigned x; volatile LAS unsigned* st; };
__device__ __forceinline__ XcdBarrier xcd_barrier_post(unsigned* bar, volatile LAS unsigned* st) {
    XcdBarrier b; b.bar = bar; b.x = xb_xcc_id(); b.st = st;
    if (threadIdx.x == 0) (void)xb_add(&bar[XB_XCNT(b.x)], 1u);
    return b;
}
__device__ __forceinline__ void xcd_barrier_complete(unsigned* bar, unsigned x, unsigned& nloc, unsigned& nx) {
    const unsigned G = gridDim.x * gridDim.y * gridDim.z;
    unsigned sum, cnt, mine, sp = 0u;
    for (;;) {
        sum = 0u; cnt = 0u; mine = 0u;
        unsigned cv[16];
        { const unsigned* p0 = bar + XB_XCNT(0); const unsigned* p1 = bar + XB_XCNT(8);
          asm volatile("global_load_dword %0, %8, off sc1\n\tglobal_load_dword %1, %8, off offset:256 sc1\n\tglobal_load_dword %2, %8, off offset:512 sc1\n\tglobal_load_dword %3, %8, off offset:768 sc1\n\t"
                       "global_load_dword %4, %8, off offset:1024 sc1\n\tglobal_load_dword %5, %8, off offset:1280 sc1\n\tglobal_load_dword %6, %8, off offset:1536 sc1\n\tglobal_load_dword %7, %8, off offset:1792 sc1\n\ts_waitcnt vmcnt(0)"
                       : "=&v"(cv[0]), "=&v"(cv[1]), "=&v"(cv[2]), "=&v"(cv[3]), "=&v"(cv[4]), "=&v"(cv[5]), "=&v"(cv[6]), "=&v"(cv[7]) : "v"(p0) : "memory");
          asm volatile("global_load_dword %0, %8, off sc1\n\tglobal_load_dword %1, %8, off offset:256 sc1\n\tglobal_load_dword %2, %8, off offset:512 sc1\n\tglobal_load_dword %3, %8, off offset:768 sc1\n\t"
                       "global_load_dword %4, %8, off offset:1024 sc1\n\tglobal_load_dword %5, %8, off offset:1280 sc1\n\tglobal_load_dword %6, %8, off offset:1536 sc1\n\tglobal_load_dword %7, %8, off offset:1792 sc1\n\ts_waitcnt vmcnt(0)"
                       : "=&v"(cv[8]), "=&v"(cv[9]), "=&v"(cv[10]), "=&v"(cv[11]), "=&v"(cv[12]), "=&v"(cv[13]), "=&v"(cv[14]), "=&v"(cv[15]) : "v"(p1) : "memory"); }
#pragma unroll
        for (unsigned j = 0; j < 16; ++j) { const unsigned c = cv[j]; sum += c; cnt += (c > 0u) ? 1u : 0u; mine = (j == x) ? c : mine; }
        if (sum == G) break;
        __builtin_amdgcn_s_sleep(1);
        if ((++sp & 255u) == 0u) { if (xb_ld(&bar[XB_TMO])) break; if (sp > XB_SPIN_CAP) { atomicAdd(&bar[XB_TMO], 1u); break; } }
    }
    nloc = mine > 0u ? mine : 1u; nx = cnt > 0u ? cnt : 1u;
}
__device__ __forceinline__ void xcd_barrier(const XcdBarrier& b) {
    asm volatile("s_waitcnt vmcnt(0)" ::: "memory");
    __syncthreads();
    if (threadIdx.x == 0) {
        unsigned* bar = b.bar;
        __builtin_amdgcn_s_waitcnt(0);
        unsigned nloc = b.st[0], nx = b.st[1];
        if (nloc == 0u) { xcd_barrier_complete(bar, b.x, nloc, nx); b.st[0] = nloc; b.st[1] = nx; }
        const unsigned old = xb_add(&bar[XB_XSUB(b.x)], 1u);
        const unsigned gen = old / nloc;
        if (old + 1u == (gen + 1u) * nloc) {
            __builtin_amdgcn_fence(__ATOMIC_RELEASE, "agent");
            asm volatile("s_waitcnt vmcnt(0)" ::: "memory");
            const unsigned og = xb_add(&bar[XB_TOP], 1u);
            const unsigned tg = og / nx;
            if (og + 1u == (tg + 1u) * nx) xb_add(&bar[XB_TOPGEN], 1u);
            else XB_SPIN(xb_ld(&bar[XB_TOPGEN]) == tg, bar);
            __builtin_amdgcn_fence(__ATOMIC_ACQUIRE, "agent");
            xb_add(&bar[XB_XGEN(b.x)], 1u);
            asm volatile("s_waitcnt vmcnt(0)" ::: "memory");
        } else {
            XB_SPIN(xb_ld(&bar[XB_XGEN(b.x)]) == gen, bar);
            __builtin_amdgcn_fence(__ATOMIC_ACQUIRE, "agent");
            asm volatile("s_waitcnt vmcnt(0)" ::: "memory");
        }
    }
    __syncthreads();
}

__device__ __forceinline__ unsigned lb_rmw(unsigned* p, unsigned v) {
    unsigned r; asm volatile("global_atomic_add %0, %1, %2, off sc0\n\ts_waitcnt vmcnt(0)" : "=v"(r) : "v"(p), "v"(v) : "memory"); return r; }
__device__ __forceinline__ void group_barrier(unsigned* bar, unsigned* cnt, volatile LAS unsigned* gen) {
    asm volatile("s_waitcnt vmcnt(0)" ::: "memory");
    __syncthreads();
    if (threadIdx.x == 0) {
        __builtin_amdgcn_s_waitcnt(0);
        const unsigned target = gen[0] + 32u; gen[0] = target;
        (void)lb_rmw(cnt, 1u);
        XB_SPIN(lb_rmw(cnt, 0u) < target, bar);
        __builtin_amdgcn_fence(__ATOMIC_ACQUIRE, "agent");
        asm volatile("s_waitcnt vmcnt(0)" ::: "memory");
    }
    __syncthreads();
}

constexpr int RING_BYTES = 131072;
constexpr int SLDS_BYTES = NCH * 256 * 4;
constexpr int MISC_OFF = SLDS_BYTES;
constexpr int LDS_BYTES = SLDS_BYTES + 1024;
constexpr int NWAVES = 8;

namespace pg8 {
constexpr int BM = 256, BK = 64, HALF = 128, HTB = HALF * BK * 2, NXCD = 8, WGM = 8;
__host__ __device__ __forceinline__ int lds_byte(int r, int c) { const int st = (r >> 4) * 2 + (c >> 5), rr = r & 15, cc = c & 31, ob = rr * 64 + cc * 2; return st * 1024 + (ob ^ (((ob >> 9) & 1) << 5)); }
__host__ __device__ __forceinline__ void stage_rc(int b, int& R, int& C) { const int st = b / 1024, sb = b % 1024, swz = sb ^ (((sb >> 9) & 1) << 5); R = (st >> 1) * 16 + swz / 64; C = (st & 1) * 32 + (swz % 64) / 2; }
__host__ __device__ __forceinline__ int perm32(int rho) { const int n = rho >> 4, i = rho & 15; return 8 * (i >> 2) + 4 * n + (i & 3); }

struct Unit { int pm, pn, e, pbase, cnt; };

struct Sched {
    int nM, nN, nwg, G, c, mode, wgm;
    const int* list; const LAS int* lcnt;
    __device__ __forceinline__ void init(int nM_, int nN_, int G_, int c_, int mode_) { nM = nM_; nN = nN_; nwg = nM * nN; G = G_; c = c_; mode = mode_; wgm = (nM_ == 72) ? 9 : WGM; list = nullptr; lcnt = nullptr; }
    __device__ __forceinline__ void init_cnt(const LAS int* lcnt_, const int* list_, int nN_, int G_, int c_) {
        lcnt = lcnt_; list = list_; int tot = 0;
#pragma unroll
        for (int e = 0; e < 8; ++e) tot += (__builtin_amdgcn_readfirstlane(lcnt_[e]) + 255) >> 8;
        nM = tot; nN = nN_; nwg = nM * nN; G = G_; c = c_; mode = 2; wgm = (tot == 72) ? 9 : WGM;
    }
    __device__ __forceinline__ bool next(int i, Unit& u) const {
        const long L = (long)i * G + c; if (L >= nwg) return false;
        int wgid = (int)L; { const int q = nwg / NXCD, r = nwg % NXCD, xcd = wgid % NXCD, off = wgid / NXCD; wgid = (xcd < r ? xcd * (q + 1) : r * (q + 1) + (xcd - r) * q) + off; }
        const int nig = wgm * nN, gid = wgid / nig, fm = gid * wgm, gsz = (nM - fm) < wgm ? (nM - fm) : wgm;
        const int pmi = fm + ((wgid % nig) % gsz); u.pn = (wgid % nig) / gsz; u.e = 0; u.pbase = 0; u.cnt = 0;
        if (mode == 0) u.pm = pmi;
        else if (mode == 1) u.pm = (pmi >> 3) * 9 + 1 + (pmi & 7);
        else { u.pm = pmi; int acc = 0, e = 0, pbase = 0, cnt = 0; bool found = false;
#pragma unroll
            for (int k = 0; k < 8; ++k) { const int ck = __builtin_amdgcn_readfirstlane(lcnt[k]); const int np = (ck + 255) >> 8;
                if (!found && pmi < acc + np) { found = true; e = k; pbase = acc; cnt = ck; } acc += np; }
            u.e = e; u.pbase = pbase; u.cnt = cnt; }
        return true;
    }
};

__device__ __forceinline__ unsigned cvt_pk_bf16(float lo, float hi) { unsigned r; asm volatile("v_cvt_pk_bf16_f32 %0, %1, %2" : "=v"(r) : "v"(lo), "v"(hi)); return r; }

template <class Epi, bool GATHER, bool F8>
__device__ __forceinline__ void gemm_phase(const int tid, LAS unsigned char* lds, const void* Abase, const void* Btbase, const int KB, const size_t estrideB  , const Sched& S, const Epi& E) {
    const int wid = __builtin_amdgcn_readfirstlane(tid >> 6), lane = tid & 63, wr = wid >> 2, wc = wid & 3, fr = lane & 15, fq = lane >> 4;
    const int nt = KB / 128;
    unsigned voffA[2], voffB[2];
#pragma unroll
    for (int i = 0; i < 2; ++i) { int R, C; stage_rc(tid * 16 + i * 8192, R, C); const int Rb = Epi::PERM ? ((R & ~31) + perm32(R & 31)) : R; voffA[i] = (unsigned)(R * KB + C * 2); voffB[i] = (unsigned)(Rb * KB + C * 2); }
    const size_t kstep = (size_t)(BK * 2);
    const size_t hstep = (size_t)HALF * KB;
    const size_t tstep = 2 * hstep;
    const unsigned ldsw = (unsigned)wid * 1024u;
    const int aoff = lds_byte(wr * 64 + fr, fq * 8), boff = lds_byte(wc * 32 + fr, fq * 8);
#define PG8_SA(b, h) (((b) * 2 + (h)) * HTB)
#define PG8_SB(b, h) ((4 + (b) * 2 + (h)) * HTB)
#define PG8_STAGE(bufoff, gbase, voff) do { _Pragma("unroll") for (int _i = 0; _i < 2; ++_i) \
        __builtin_amdgcn_global_load_lds((const unsigned*)((const char*)(gbase) + (voff)[_i]), (LAS unsigned*)(lds + (bufoff) + ldsw + _i * 8192), 16, 0, 0); } while (0)
#define PG8_STAGE_A(bufoff, gbase, h, NX) do { if constexpr (GATHER) { unsigned _v[2]; _v[0] = (NX) ? vN[h][0] : vC[h][0]; _v[1] = (NX) ? vN[h][1] : vC[h][1]; PG8_STAGE(bufoff, gbase, _v); } \
        else { PG8_STAGE(bufoff, (gbase) + (h) * hstep, voffA); } } while (0)
#define PG8_LDA(dst, b, h) do { _Pragma("unroll") for (int m = 0; m < 4; ++m) _Pragma("unroll") for (int k = 0; k < 2; ++k) dst[m][k] = *(const LAS bf16x8*)(lds + PG8_SA(b, h) + aoff + m * 2048 + k * 1024); } while (0)
#define PG8_LDB(dst, b, h) do { _Pragma("unroll") for (int n = 0; n < 2; ++n) _Pragma("unroll") for (int k = 0; k < 2; ++k) dst[n][k] = *(const LAS bf16x8*)(lds + PG8_SB(b, h) + boff + n * 2048 + k * 1024); } while (0)
#define PG8_MMA(ai, bj, At, Bt) do { __builtin_amdgcn_s_setprio(1); \
        if constexpr (F8) { _Pragma("unroll") for (int m = 0; m < 4; ++m) _Pragma("unroll") for (int n = 0; n < 2; ++n) { \
            const i32x8 _b = __builtin_shufflevector(__builtin_bit_cast(i32x4, Bt[n][0]), __builtin_bit_cast(i32x4, Bt[n][1]), 0, 1, 2, 3, 4, 5, 6, 7); \
            const i32x8 _a = __builtin_shufflevector(__builtin_bit_cast(i32x4, At[m][0]), __builtin_bit_cast(i32x4, At[m][1]), 0, 1, 2, 3, 4, 5, 6, 7); \
            asm volatile("v_mfma_f32_16x16x128_f8f6f4 %0, %1, %2, %0" : "+v"(acc[ai][bj][m][n]) : "v"(_b), "v"(_a)); } } \
        else { _Pragma("unroll") for (int m = 0; m < 4; ++m) _Pragma("unroll") for (int n = 0; n < 2; ++n) _Pragma("unroll") for (int k = 0; k < 2; ++k) \
            acc[ai][bj][m][n] = __builtin_amdgcn_mfma_f32_16x16x32_bf16(Bt[n][k], At[m][k], acc[ai][bj][m][n], 0, 0, 0); } \
        __builtin_amdgcn_s_setprio(0); } while (0)
#define PG8_MMAZ(ai, bj, At, Bt) do { __builtin_amdgcn_s_setprio(1); \
        if constexpr (F8) { _Pragma("unroll") for (int m = 0; m < 4; ++m) _Pragma("unroll") for (int n = 0; n < 2; ++n) { \
            const i32x8 _b = __builtin_shufflevector(__builtin_bit_cast(i32x4, Bt[n][0]), __builtin_bit_cast(i32x4, Bt[n][1]), 0, 1, 2, 3, 4, 5, 6, 7); \
            const i32x8 _a = __builtin_shufflevector(__builtin_bit_cast(i32x4, At[m][0]), __builtin_bit_cast(i32x4, At[m][1]), 0, 1, 2, 3, 4, 5, 6, 7); \
            asm volatile("v_mfma_f32_16x16x128_f8f6f4 %0, %1, %2, 0" : "=&v"(acc[ai][bj][m][n]) : "v"(_b), "v"(_a)); } } \
        else { _Pragma("unroll") for (int m = 0; m < 4; ++m) _Pragma("unroll") for (int n = 0; n < 2; ++n) { \
            acc[ai][bj][m][n] = __builtin_amdgcn_mfma_f32_16x16x32_bf16(Bt[n][0], At[m][0], (f32x4){0.f, 0.f, 0.f, 0.f}, 0, 0, 0); \
            acc[ai][bj][m][n] = __builtin_amdgcn_mfma_f32_16x16x32_bf16(Bt[n][1], At[m][1], acc[ai][bj][m][n], 0, 0, 0); } } \
        __builtin_amdgcn_s_setprio(0); } while (0)
#define PG8_WAIT_V(n) asm volatile("s_waitcnt vmcnt(" #n ")" ::: "memory")
#define PG8_WAIT_L(n) asm volatile("s_waitcnt lgkmcnt(" #n ")" ::: "memory")
#define PG8_BAR __builtin_amdgcn_s_barrier()
#define PG8_SCHED __builtin_amdgcn_sched_barrier(0)
#define PG8_AIDX(u, tX) do { const int _cnt = (u).cnt; _Pragma("unroll") for (int _h = 0; _h < 2; ++_h) _Pragma("unroll") for (int _i = 0; _i < 2; ++_i) { \
        int _R, _C; stage_rc(tid * 16 + _i * 8192, _R, _C); const int _pos = ((u).pm - (u).pbase) * 256 + _h * 128 + _R; \
        tX[_h][_i] = _pos < _cnt ? S.list[(u).e * NT + _pos] : 0; } } while (0)
#define PG8_AOFS(tX, vX) do { _Pragma("unroll") for (int _h = 0; _h < 2; ++_h) _Pragma("unroll") for (int _i = 0; _i < 2; ++_i) { \
        int _R, _C; stage_rc(tid * 16 + _i * 8192, _R, _C); vX[_h][_i] = (unsigned)(tX[_h][_i] * KB + _C * 2); } } while (0)
    Unit cur, nxt; int ui = 0;
    if (!S.next(0, cur)) return;
    f32x4 acc[2][2][4][2];
#pragma unroll
    for (int a = 0; a < 2; ++a)
#pragma unroll
        for (int b = 0; b < 2; ++b)
#pragma unroll
            for (int m = 0; m < 4; ++m)
#pragma unroll
                for (int n = 0; n < 2; ++n) acc[a][b][m][n] = (f32x4){0.f, 0.f, 0.f, 0.f};
    bf16x8 At[4][2], B0[2][2], B1[2][2];
    unsigned vC[2][2], vN[2][2]; int tI[2][2]; Unit n2; bool has_n2 = false;
    if constexpr (GATHER) {
        PG8_AIDX(cur, tI); PG8_AOFS(tI, vC);
        if (S.next(1, n2)) { PG8_AIDX(n2, tI); PG8_AOFS(tI, vN); } else { PG8_AOFS(tI, vN); }
        VM_WAIT(); }
    const char* cA = (const char*)Abase + (GATHER ? (size_t)0 : (size_t)cur.pm * tstep);
    const char* cB = (const char*)Btbase + (size_t)cur.e * estrideB + (size_t)cur.pn * tstep;
    PG8_STAGE(PG8_SB(0, 0), cB, voffB); PG8_STAGE(PG8_SB(0, 1), cB + hstep, voffB); PG8_STAGE_A(PG8_SA(0, 0), cA, 0, false); PG8_STAGE_A(PG8_SA(0, 1), cA, 1, false);
    if (wr == 1) PG8_BAR;
    PG8_WAIT_V(2); PG8_BAR;
    PG8_STAGE(PG8_SB(1, 0), cB + kstep, voffB); PG8_STAGE_A(PG8_SA(1, 0), cA + kstep, 0, false); PG8_STAGE(PG8_SB(1, 1), cB + hstep + kstep, voffB);
    PG8_WAIT_V(6); PG8_BAR;
    for (;;) {
        const bool has_next = S.next(ui + 1, nxt);
        const char* nA = has_next ? (const char*)Abase + (GATHER ? (size_t)0 : (size_t)nxt.pm * tstep) : cA;
        const char* nB = has_next ? (const char*)Btbase + (size_t)nxt.e * estrideB + (size_t)nxt.pn * tstep : cB;
        for (int t = 0; t < nt; t += 2) {
            const bool last = (t == nt - 2);
            const char* a1 = cA + (size_t)(t + 1) * kstep;
            const char* a2 = last ? nA : cA + (size_t)(t + 2) * kstep; const char* b2 = last ? nB : cB + (size_t)(t + 2) * kstep;
            const char* a3 = a2 + kstep; const char* b3 = b2 + kstep;
            PG8_LDB(B0, 0, 0); PG8_LDB(B1, 0, 1); PG8_SCHED; PG8_LDA(At, 0, 0); PG8_STAGE_A(PG8_SA(1, 1), a1, 1, false);
            PG8_WAIT_V(8); PG8_WAIT_L(0); PG8_BAR; if (F8 && t == 0) { PG8_MMAZ(0, 0, At, B0); PG8_MMAZ(0, 1, At, B1); } else { PG8_MMA(0, 0, At, B0); PG8_MMA(0, 1, At, B1); } PG8_BAR; PG8_SCHED;
            PG8_LDA(At, 0, 1); PG8_STAGE(PG8_SB(0, 0), b2, voffB); PG8_STAGE(PG8_SB(0, 1), b2 + hstep, voffB); PG8_STAGE_A(PG8_SA(0, 0), a2, 0, last);
            PG8_WAIT_V(8); PG8_WAIT_L(0); PG8_BAR; if (F8 && t == 0) { PG8_MMAZ(1, 0, At, B0); PG8_MMAZ(1, 1, At, B1); } else { PG8_MMA(1, 0, At, B0); PG8_MMA(1, 1, At, B1); } PG8_BAR; PG8_SCHED;
            PG8_LDB(B0, 1, 0); PG8_LDB(B1, 1, 1); PG8_SCHED; PG8_LDA(At, 1, 0); PG8_STAGE_A(PG8_SA(0, 1), a2, 1, last);
            PG8_WAIT_V(8); PG8_WAIT_L(0); PG8_BAR; PG8_MMA(0, 0, At, B0); PG8_MMA(0, 1, At, B1); PG8_BAR; PG8_SCHED;
            PG8_LDA(At, 1, 1); PG8_STAGE(PG8_SB(1, 0), b3, voffB); PG8_STAGE(PG8_SB(1, 1), b3 + hstep, voffB); PG8_STAGE_A(PG8_SA(1, 0), a3, 0, last);
            PG8_WAIT_V(8); PG8_WAIT_L(0); PG8_BAR; PG8_MMA(1, 0, At, B0); PG8_MMA(1, 1, At, B1); PG8_BAR; PG8_SCHED;
        }
        if (wr == 0) PG8_BAR;
        if constexpr (F8) { asm volatile("s_nop 15\n\ts_nop 15" ::: "memory"); }
        if constexpr (GATHER) { has_n2 = has_next && S.next(ui + 2, n2); if (has_n2) { PG8_AIDX(n2, tI); } }
        { int fr_ = fr, fq_ = fq; asm volatile("" : "+v"(fr_), "+v"(fq_));
          E(acc, cur, wr, wc, fr_, fq_); }
        if (!has_next) break;
        if constexpr (!F8) {
#pragma unroll
        for (int a = 0; a < 2; ++a)
#pragma unroll
            for (int b = 0; b < 2; ++b)
#pragma unroll
                for (int m = 0; m < 4; ++m)
#pragma unroll
                    for (int n = 0; n < 2; ++n) acc[a][b][m][n] = (f32x4){0.f, 0.f, 0.f, 0.f}; }
        cur = nxt; cA = nA; cB = nB; ++ui;
        if constexpr (GATHER) {
#pragma unroll
            for (int h = 0; h < 2; ++h)
#pragma unroll
                for (int i = 0; i < 2; ++i) vC[h][i] = vN[h][i];
            if (has_n2) { PG8_AOFS(tI, vN); } }
        if (wr == 1) PG8_BAR;
    }
    PG8_WAIT_V(0);
    PG8_BAR;
#undef PG8_SA
#undef PG8_SB
#undef PG8_STAGE
#undef PG8_STAGE_A
#undef PG8_LDA
#undef PG8_LDB
#undef PG8_MMA
#undef PG8_MMAZ
#undef PG8_WAIT_V
#undef PG8_WAIT_L
#undef PG8_BAR
#undef PG8_SCHED
#undef PG8_AIDX
#undef PG8_AOFS
}
}

struct Args { const float* in[33]; float* out; unsigned char* ws; int ph_lo, ph_hi; };
enum InIdx { I_X = 0, I_C, I_CTX, I_CCTX, I_ADAW, I_ADAB, I_WIN, I_WOUT, I_RPB, I_GQ, I_GK, I_LRE, I_LIM, I_LSTEP, I_BRE, I_BIM, I_CRE, I_CIM, I_SSMD, I_WGLU, I_SINK,
             I_LN1G, I_LN1B, I_LN2G, I_LN2B, I_FG, I_FU, I_FD, I_MR, I_MBR, I_MG, I_MU, I_MD };
struct InTab {
    const LAS unsigned long long* t;
    __device__ __forceinline__ const float* operator[](int i) const { const unsigned long long v = t[i];
        const unsigned lo = __builtin_amdgcn_readfirstlane((unsigned)v), hi = __builtin_amdgcn_readfirstlane((unsigned)(v >> 32)); return (const float*)(((unsigned long long)hi << 32) | lo); }
};
struct Frame {
    LAS unsigned char* lds; int tid, lane, wave, G, gw, NGW, vcu;
    InTab in; float* out; unsigned char* ws;
    unsigned* ctl; float* mods; float* rope; float* H; float* Y; bf16* ABF; unsigned char* big;
};
__device__ __forceinline__ const float* modp(const Frame& F, int layer, int bb, int chunk) { return F.mods + ((size_t)(layer * 9 + bb) * 6 + chunk) * 1024; }

using pg8::Unit;
struct EpiInProj {
    static constexpr bool PERM = true;
    unsigned char* big; const float* gq; const float* gk; const float* rope;
    __device__ __forceinline__ void operator()(f32x4 (&acc)[2][2][4][2], const Unit& u, int wr, int wc, int fr, int fq) const {
        const int b = u.pm / 9, pb = u.pm - b * 9;
        const int pn = u.pn;
        const bool is_v = (pn == 2) || ((pn == 4 || pn == 7) && wc >= 2);
        const bool do_norm = (pn == 3) || (pn == 4 && wc < 2);
        const bool do_rope = (pb != 0) && ((pn == 3) || (pn == 6) || ((pn == 4 || pn == 7) && wc < 2));
        const bool do_qs = (pn == 0) || (pn == 3) || (pn == 6);
        if (do_norm) {
            const float* gn = (pn == 3) ? gq : gk;
            f32x4 g4[2][2];
#pragma unroll
            for (int bj = 0; bj < 2; ++bj)
#pragma unroll
                for (int n = 0; n < 2; ++n) g4[bj][n] = ldgf4(gn + 32 * bj + 8 * fq + 4 * n);
#pragma unroll
            for (int ai = 0; ai < 2; ++ai)
#pragma unroll
                for (int m = 0; m < 4; ++m) {
                    float ss = 0.f;
#pragma unroll
                    for (int bj = 0; bj < 2; ++bj)
#pragma unroll
                        for (int n = 0; n < 2; ++n) { const f32x4 x = acc[ai][bj][m][n]; ss += (x[0] * x[0] + x[1] * x[1]) + (x[2] * x[2] + x[3] * x[3]); }
                    ss += __shfl_xor(ss, 16); ss += __shfl_xor(ss, 32);
                    const float rinv = __builtin_amdgcn_rsqf(ss * (1.0f / 64.0f) + 1e-6f);
#pragma unroll
                    for (int bj = 0; bj < 2; ++bj)
#pragma unroll
                        for (int n = 0; n < 2; ++n) acc[ai][bj][m][n] = acc[ai][bj][m][n] * rinv * g4[bj][n];
                }
        }
        if (do_rope) {
            const float* rp = rope + (size_t)((pb - 1) * 256 + wr * 64 + fr) * 32 + 8 * fq;
#define RP_LOAD(rg, C_, S_) do { _Pragma("unroll") for (int n = 0; n < 2; ++n) { C_[n] = ldgf4(rp + (size_t)(((rg) >> 2) * 128 + ((rg) & 3) * 16) * 32 + 4 * n); S_[n] = ldgf4(rp + 65536 + (size_t)(((rg) >> 2) * 128 + ((rg) & 3) * 16) * 32 + 4 * n); } } while (0)
#define RP_ROT(rg, C_, S_) do { _Pragma("unroll") for (int n = 0; n < 2; ++n) { const f32x4 x1 = acc[(rg) >> 2][0][(rg) & 3][n], x2 = acc[(rg) >> 2][1][(rg) & 3][n]; \
            acc[(rg) >> 2][0][(rg) & 3][n] = x1 * C_[n] - x2 * S_[n]; acc[(rg) >> 2][1][(rg) & 3][n] = x1 * S_[n] + x2 * C_[n]; } } while (0)
            f32x4 cA[2], sA[2], cB[2], sB[2], cC[2], sC[2];
            RP_LOAD(0, cA, sA); RP_LOAD(1, cB, sB); RP_LOAD(2, cC, sC);
            RP_ROT(0, cA, sA); RP_LOAD(3, cA, sA); RP_ROT(1, cB, sB); RP_LOAD(4, cB, sB); RP_ROT(2, cC, sC); RP_LOAD(5, cC, sC);
            RP_ROT(3, cA, sA); RP_LOAD(6, cA, sA); RP_ROT(4, cB, sB); RP_LOAD(7, cB, sB); RP_ROT(5, cC, sC); RP_ROT(6, cA, sA); RP_ROT(7, cB, sB);
#undef RP_LOAD
#undef RP_ROT
        }
        const float qs = do_qs ? QSCALE : 1.0f;
        if (is_v) {
            bf16* vt; int nh, hh;
            if (pn == 2) { vt = (bf16*)(big + BG_VAT); nh = 4; hh = wc; } else if (pn == 4) { vt = (bf16*)(big + BG_VBT); nh = 2; hh = wc - 2; } else { vt = (bf16*)(big + BG_VDT); nh = 2; hh = wc - 2; }
            GAS bf16* vb = (GAS bf16*)(vt + (size_t)(b * nh + hh) * 64 * TPB) + (pb * 8 + wr * 2) * 2048 + (fr >> 3) * 128 + (fr & 7) + (fq >> 1) * 512 + (8 * (fq & 1)) * 8;
#pragma unroll
            for (int ai = 0; ai < 2; ++ai)
#pragma unroll
                for (int m = 0; m < 4; ++m) {
                    const int kb = (4 * ai + (m >> 1)) * 2048 + (m & 1) * 256;
                    const int odd = fr & 1;
#pragma unroll
                    for (int bj = 0; bj < 2; ++bj)
#pragma unroll
                        for (int j = 0; j < 4; ++j) {
                            const float a = acc[ai][bj][m][0][j], c = acc[ai][bj][m][1][j];
                            const float na = dpp_mov<0xB1>(a), nc = dpp_mov<0xB1>(c);
                            const unsigned w = pk2(odd ? nc : a, odd ? c : na);
                            *(GAS unsigned*)(vb + kb + (2 * bj) * 512 + (4 * odd + j) * 8 - odd) = w;
                        }
                }
            return;
        }
        if (pn == 5) {
            bf16* ug = (bf16*)(big + BG_UG) + ((((size_t)(4 * wc + (fq >> 1)) * 72 + u.pm) * 8 + (fr >> 1)) * 64 + (2 * (fr & 1) + (fq & 1)) * 16 + 4 * wr) * 8;
#pragma unroll
            for (int ai = 0; ai < 2; ++ai)
#pragma unroll
                for (int m = 0; m < 4; ++m) {
#pragma unroll
                    for (int bj = 0; bj < 2; ++bj) {
                        const f32x4 v0 = acc[ai][bj][m][0], v1 = acc[ai][bj][m][1];
                        u32x4 w; w.x = pk2(v0[0], v0[1]); w.y = pk2(v0[2], v0[3]); w.z = pk2(v1[0], v1[1]); w.w = pk2(v1[2], v1[3]);
                        stg4(ug + (size_t)(2 * bj) * 72 * 8 * 512 + (8 * ai + m) * 8, w);
                    }
                }
            return;
        }
        if (pn == 0 || pn == 3 || pn == 6) {
            bf16* dst = (bf16*)(big + (pn == 0 ? BG_QA : pn == 3 ? BG_QB : BG_QD));
#pragma unroll
            for (int ai = 0; ai < 2; ++ai)
#pragma unroll
                for (int m = 0; m < 4; ++m) {
                    const size_t row = (size_t)u.pm * 256 + ai * 128 + wr * 64 + m * 16 + fr;
#pragma unroll
                    for (int bj = 0; bj < 2; ++bj) {
                        const f32x4 v0 = acc[ai][bj][m][0] * qs, v1 = acc[ai][bj][m][1] * qs;
                        u32x4 w; w.x = pk2(v0[0], v0[1]); w.y = pk2(v0[2], v0[3]); w.z = pk2(v1[0], v1[1]); w.w = pk2(v1[2], v1[3]);
                        stg4(dst + row * 256 + 64 * wc + 32 * bj + 8 * fq, w);
                    }
                }
            return;
        }
        {
            bf16* kt; int nh;
            if (pn == 1) { kt = (bf16*)(big + BG_KA); nh = 4; } else if (pn == 4) { kt = (bf16*)(big + BG_KB); nh = 2; } else { kt = (bf16*)(big + BG_KD); nh = 2; }
            bf16* kb = kt + (size_t)(b * nh + wc) * 64 * TPB + ((pb * 8 + wr * 2) * 4 + ((fr >> 2) & 1) * 2) * 512 + (fq * 16 + 4 * (fr >> 3) + (fr & 3)) * 8;
#pragma unroll
            for (int ai = 0; ai < 2; ++ai)
#pragma unroll
                for (int m = 0; m < 4; ++m) {
                    const int base = (4 * ai + (m >> 1)) * 2048 + (m & 1) * 64;
#pragma unroll
                    for (int bj = 0; bj < 2; ++bj) {
                        const f32x4 v0 = acc[ai][bj][m][0], v1 = acc[ai][bj][m][1];
                        u32x4 w; w.x = pk2(v0[0], v0[1]); w.y = pk2(v0[2], v0[3]); w.z = pk2(v1[0], v1[1]); w.w = pk2(v1[2], v1[3]);
                        stg4(kb + base + bj * 512, w);
                    }
                }
        }
    }
};
struct EpiResid {
    static constexpr bool PERM = false;
    const float* H; float* Y; const float* mods_layer; int gchunk;
    int src; const float* lng; const float* lnb; const float* stats; float ascale;
    __device__ __forceinline__ void operator()(f32x4 (&acc)[2][2][4][2], const Unit& u, int wr, int wc, int fr, int fq) const {
        const int b = u.pm / 9, pb = u.pm - b * 9, bb = pb == 0 ? 8 : b;
        const int col0 = u.pn * 256 + wc * 32 + 4 * fq;
        const float* gp = mods_layer + ((size_t)bb * 6 + gchunk) * 1024 + col0;
        f32x4 gv[2][2], g4[2][2], b4[2][2];
#pragma unroll
        for (int bj = 0; bj < 2; ++bj)
#pragma unroll
            for (int n = 0; n < 2; ++n) { gv[bj][n] = ldgf4(gp + bj * 128 + n * 16); g4[bj][n] = ldgf4(lng + col0 + bj * 128 + n * 16); b4[bj][n] = ldgf4(lnb + col0 + bj * 128 + n * 16); }
#pragma unroll
        for (int bj = 0; bj < 2; ++bj)
#pragma unroll
            for (int n = 0; n < 2; ++n) { gv[bj][n] = gv[bj][n] * ascale; g4[bj][n] = g4[bj][n] * ALPHA; b4[bj][n] = b4[bj][n] * ALPHA; }
#define ER_ROW(rg) ((size_t)u.pm * 256 + ((rg) >> 2) * 128 + wr * 64 + ((rg) & 3) * 16 + fr)
#define ER_LOAD(sg, Yr, Sr) do { const size_t _row = ER_ROW((sg) >> 1); \
        if (src == 0) { const int _rr = ((sg) >> 3) * 128 + wr * 64 + (((sg) >> 1) & 3) * 16 + fr; \
            const float* _h = (pb == 0 ? lng + ((size_t)b * 256 + _rr) * 1024 : H + ((size_t)b * 2048 + (pb - 1) * 256 + _rr) * 1024) + col0 + ((sg) & 1) * 128;        \
            _Pragma("unroll") for (int n = 0; n < 2; ++n) Yr[n] = ldgf4(_h + n * 16); Sr = (f32x2){0.f, 1.f}; } \
        else { Sr = *(const GAS f32x2*)(stats + 2 * _row); \
            _Pragma("unroll") for (int n = 0; n < 2; ++n) Yr[n] = ldgf4(Y + _row * 1024 + col0 + ((sg) & 1) * 128 + n * 16); } } while (0)
#define ER_CS(sg, Yr, Sr) do { const size_t _off = ER_ROW((sg) >> 1) * 1024 + col0 + ((sg) & 1) * 128; \
        _Pragma("unroll") for (int n = 0; n < 2; ++n) { \
            const f32x4 _h = src == 0 ? Yr[n] * ALPHA : (Yr[n] - Sr[0]) * Sr[1] * g4[(sg) & 1][n] + b4[(sg) & 1][n];        \
            stgf4(Y + _off + n * 16, _h + gv[(sg) & 1][n] * acc[(sg) >> 3][(sg) & 1][((sg) >> 1) & 3][n]); } } while (0)
        f32x4 ya[2], yb[2], yc[2]; f32x2 sa, sb, sc_;
        ER_LOAD(0, ya, sa); ER_LOAD(1, yb, sb); ER_LOAD(2, yc, sc_);
        ER_CS(0, ya, sa); ER_LOAD(3, ya, sa);   ER_CS(1, yb, sb); ER_LOAD(4, yb, sb);   ER_CS(2, yc, sc_); ER_LOAD(5, yc, sc_);
        ER_CS(3, ya, sa); ER_LOAD(6, ya, sa);   ER_CS(4, yb, sb); ER_LOAD(7, yb, sb);   ER_CS(5, yc, sc_); ER_LOAD(8, yc, sc_);
        ER_CS(6, ya, sa); ER_LOAD(9, ya, sa);   ER_CS(7, yb, sb); ER_LOAD(10, yb, sb);  ER_CS(8, yc, sc_); ER_LOAD(11, yc, sc_);
        ER_CS(9, ya, sa); ER_LOAD(12, ya, sa);  ER_CS(10, yb, sb); ER_LOAD(13, yb, sb); ER_CS(11, yc, sc_); ER_LOAD(14, yc, sc_);
        ER_CS(12, ya, sa); ER_LOAD(15, ya, sa); ER_CS(13, yb, sb); ER_CS(14, yc, sc_);  ER_CS(15, ya, sa);
#undef ER_ROW
#undef ER_LOAD
#undef ER_CS
    }
};
template <bool OUT8> struct EpiSwiglu {
    static constexpr bool PERM = true;
    void* act; int ldc; float scale;
    __device__ __forceinline__ void operator()(f32x4 (&acc)[2][2][4][2], const Unit& u, int wr, int wc, int fr, int fq) const {
#pragma unroll
        for (int ai = 0; ai < 2; ++ai)
#pragma unroll
            for (int m = 0; m < 4; ++m) {
                const size_t row = (size_t)u.pm * 256 + ai * 128 + wr * 64 + m * 16 + fr;
                const float k1 = -scale * LOG2E, c2 = scale * scale * (OUT8 ? 8.0f : 1.0f);
                f32x4 o0, o1;
                { const f32x4 G = acc[ai][0][m][0], U = acc[ai][1][m][0]; const f32x4 A = G * k1; f32x4 T; T[0] = ex2(A[0]); T[1] = ex2(A[1]); T[2] = ex2(A[2]); T[3] = ex2(A[3]);
                  const f32x4 D = T + 1.0f; f32x4 R; R[0] = rcpf_(D[0]); R[1] = rcpf_(D[1]); R[2] = rcpf_(D[2]); R[3] = rcpf_(D[3]); o0 = (G * U) * (R * c2); }
                { const f32x4 G = acc[ai][0][m][1], U = acc[ai][1][m][1]; const f32x4 A = G * k1; f32x4 T; T[0] = ex2(A[0]); T[1] = ex2(A[1]); T[2] = ex2(A[2]); T[3] = ex2(A[3]);
                  const f32x4 D = T + 1.0f; f32x4 R; R[0] = rcpf_(D[0]); R[1] = rcpf_(D[1]); R[2] = rcpf_(D[2]); R[3] = rcpf_(D[3]); o1 = (G * U) * (R * c2); }
                if constexpr (OUT8) stg2((unsigned char*)act + row * ldc + u.pn * 128 + wc * 32 + 8 * fq, (u32x2){pk4_fp8(o0[0], o0[1], o0[2], o0[3]), pk4_fp8(o1[0], o1[1], o1[2], o1[3])});
                else { u32x4 w; w.x = pk2(o0[0], o0[1]); w.y = pk2(o0[2], o0[3]); w.z = pk2(o1[0], o1[1]); w.w = pk2(o1[2], o1[3]); stg4((bf16*)act + row * ldc + u.pn * 128 + wc * 32 + 8 * fq, w); }
            }
    }
};
struct EpiBf16Out {
    static constexpr bool PERM = true;
    bf16* O; float scale;
    __device__ __forceinline__ void operator()(f32x4 (&acc)[2][2][4][2], const Unit& u, int wr, int wc, int fr, int fq) const {
#pragma unroll
        for (int ai = 0; ai < 2; ++ai)
#pragma unroll
            for (int m = 0; m < 4; ++m) {
                const size_t row = (size_t)u.pm * 256 + ai * 128 + wr * 64 + m * 16 + fr;
#pragma unroll
                for (int bj = 0; bj < 2; ++bj) {
                    const f32x4 v0 = acc[ai][bj][m][0] * scale, v1 = acc[ai][bj][m][1] * scale;
                    u32x4 w; w.x = pk2(v0[0], v0[1]); w.y = pk2(v0[2], v0[3]); w.z = pk2(v1[0], v1[1]); w.w = pk2(v1[2], v1[3]);
                    stg4(O + row * 1024 + u.pn * 256 + bj * 128 + wc * 32 + 8 * fq, w);
                }
            }
    }
};

__device__ __forceinline__ int slot_of(int mode, int c) {
    if (mode == 0) return c;
    if (mode == 1) { const int tile = c >> 8, lc = c & 255, wc = lc >> 6, d = lc & 63; return tile * 256 + 128 * (d >> 5) + 32 * wc + (d & 31); }
    return 256 * (c >> 7) + (c & 127) + (mode == 3 ? 128 : 0);
}
__device__ __forceinline__ void transpose_tile(const float* W, int K, int Nsrc, bf16* WT, int mode, LAS unsigned* tile, int item, int tid) {
    const int nblk = Nsrc >> 8, kb = item / nblk, nb = item - kb * nblk, k0 = 128 * kb, n0 = 256 * nb;
    const int col4 = tid & 63, rb = tid >> 6;
    const float* src = W + (size_t)(k0 + 2 * rb) * Nsrc + n0 + 4 * col4;
    f32x4 va[8], vb[8];
#pragma unroll
    for (int pp = 0; pp < 8; ++pp) { va[pp] = ldgf4(src + (size_t)(16 * pp) * Nsrc); vb[pp] = ldgf4(src + (size_t)(16 * pp + 1) * Nsrc); }
#pragma unroll
    for (int pp = 0; pp < 8; ++pp) { LAS unsigned* t = tile + (rb + 8 * pp) * 257 + 4 * col4;
        t[0] = pk2(va[pp][0], vb[pp][0]); t[1] = pk2(va[pp][1], vb[pp][1]); t[2] = pk2(va[pp][2], vb[pp][2]); t[3] = pk2(va[pp][3], vb[pp][3]); }
    __syncthreads();
#pragma unroll
    for (int q = 0; q < 8; ++q) {
        const int chunk = q * 512 + tid, c = chunk & 15, n = chunk >> 4;
        const LAS unsigned* t = tile + (4 * c) * 257 + n;
        const u32x4 o = (u32x4){t[0], t[257], t[514], t[771]};
        stg4(WT + (size_t)slot_of(mode, n0 + n) * K + k0 + 8 * c, o);
    }
    __syncthreads();
}
__device__ __forceinline__ void transpose_tile8(const float* W, int K, int Nsrc, unsigned char* WT, int mode, float wscale, LAS unsigned* tile, int item, int tid) {
    const int nblk = Nsrc >> 8, kb = item / nblk, nb = item - kb * nblk, k0 = 128 * kb, n0 = 256 * nb;
    const int col4 = tid & 63, rb = tid >> 6;
    const float* src = W + (size_t)(k0 + 4 * rb) * Nsrc + n0 + 4 * col4;
#pragma unroll
    for (int pp = 0; pp < 4; ++pp) {
        const f32x4 v0 = ldgf4_nt(src + (size_t)(32 * pp) * Nsrc) * wscale, v1 = ldgf4_nt(src + (size_t)(32 * pp + 1) * Nsrc) * wscale, v2 = ldgf4_nt(src + (size_t)(32 * pp + 2) * Nsrc) * wscale, v3 = ldgf4_nt(src + (size_t)(32 * pp + 3) * Nsrc) * wscale;
        LAS unsigned* t = tile + (rb + 8 * pp) * 257 + 4 * col4;
        t[0] = pk4_fp8(v0[0], v1[0], v2[0], v3[0]); t[1] = pk4_fp8(v0[1], v1[1], v2[1], v3[1]); t[2] = pk4_fp8(v0[2], v1[2], v2[2], v3[2]); t[3] = pk4_fp8(v0[3], v1[3], v2[3], v3[3]);
    }
    __syncthreads();
#pragma unroll
    for (int q = 0; q < 4; ++q) {
        const int chunk = q * 512 + tid, c = chunk & 7, n = chunk >> 3;
        const LAS unsigned* t = tile + (4 * c) * 257 + n;
        const u32x4 o = (u32x4){t[0], t[257], t[514], t[771]};
        stg4_nt(WT + (size_t)slot_of(mode, n0 + n) * K + k0 + 16 * c, o);
    }
    __syncthreads();
}
struct SsmP { float lr, li, step; };
struct SsmPtrs { const float* lre; const float* lim; const float* lstep; const float* bre; const float* bim; const float* cre; const float* cim; };
__device__ __forceinline__ SsmP ssm_p(const SsmPtrs& Q, int layer, int d, int g, int p) {
    SsmP r; const int i = ((layer * 2 + d) * 16 + g);
    r.lr = Q.lre[i * 64 + p]; r.li = Q.lim[i * 64 + p]; r.step = ex2(Q.lstep[i] * LOG2E); return r;
}
__device__ __forceinline__ void ssm_apow(const SsmP& q, int kk, float& re, float& im) {
    const float mag = ex2((float)kk * q.lr * q.step * LOG2E);
    double s, c; sincos_d((double)kk * (double)q.li * (double)q.step, s, c);
    re = mag * (float)c; im = mag * (float)s;
}
__device__ __forceinline__ void ssm_f(const SsmP& q, float& fre, float& fim) {
    float are, aim; ssm_apow(q, 1, are, aim);
    const float den = q.lr * q.lr + q.li * q.li, nre = are - 1.0f;
    fre = (nre * q.lr + aim * q.li) / den; fim = (aim * q.lr - nre * q.li) / den;
}

constexpr int IT_F = 8 * 11, IT_FD = 22 * 4, N_F = 2 * (2 * IT_F + IT_FD);
constexpr int FFN_EARLY = 64;
__device__ __forceinline__ void ffn_weight_item(Frame& F, const int it, LAS unsigned* tile) {
    const float* fg = F.in[I_FG]; const float* fu = F.in[I_FU]; const float* fd = F.in[I_FD];
    const int per = 2 * IT_F + IT_FD, i = it / per; const int r = it - i * per;
    bf16* gu = (bf16*)(F.ws + WS_WFGU) + (size_t)i * 5632 * 1024;
    const bool gu8 = ((F8GU_MASK >> i) & 1) != 0;
    if (r < IT_F) { if (gu8) transpose_tile8(fg + (size_t)i * 1024 * DFF, 1024, DFF, (unsigned char*)gu, 2, 128.0f, tile, r, F.tid); else transpose_tile(fg + (size_t)i * 1024 * DFF, 1024, DFF, gu, 2, tile, r, F.tid); }
    else if (r < 2 * IT_F) { if (gu8) transpose_tile8(fu + (size_t)i * 1024 * DFF, 1024, DFF, (unsigned char*)gu, 3, 128.0f, tile, r - IT_F, F.tid); else transpose_tile(fu + (size_t)i * 1024 * DFF, 1024, DFF, gu, 3, tile, r - IT_F, F.tid); }
    else transpose_tile8(fd + (size_t)i * DFF * 1024, DFF, 1024, F.ws + WS_WFD + (size_t)i * 1024 * DFF, 0, 512.0f, tile, r - 2 * IT_F, F.tid);
}
__device__ __forceinline__ void phase_p0a(Frame& F) {
    {
        LAS float* act = (LAS float*)F.lds;
        LAS float* red = act + 9 * 1024;
        const float* cvec = F.in[I_C]; const float* ccx = F.in[I_CCTX]; const float* adaw = F.in[I_ADAW]; const float* adab = F.in[I_ADAB];
        for (int i = F.tid; i < 9 * 1024; i += 512) { const int bb = i >> 10, k = i & 1023; const float x = bb < 8 ? cvec[bb * 1024 + k] : ccx[k]; act[i] = siluf_(x); }
        __syncthreads();
        for (int item = blockIdx.x; item < 4 * 24 * 2; item += F.G) {
            const int kh = item & 1, lc = item >> 1, layer = lc / 24, chunk = lc - layer * 24;
            const float* W = adaw + (size_t)layer * 1024 * 6144 + chunk * 256 + 4 * F.lane;
            f32x4 a0 = {0.f, 0.f, 0.f, 0.f}, a1 = a0, a2 = a0, a3 = a0, a4 = a0, a5 = a0, a6 = a0, a7 = a0, a8 = a0;
            const int k0 = kh * 512 + F.wave * 64;
            f32x4 wA[4], wB[4], wC[4], wD[4];
#define MODS_LD(buf, st) do { const int _k = k0 + 4 * ((st) < 15 ? (st) : 15); _Pragma("unroll") for (int q = 0; q < 4; ++q) buf[q] = ldgf4(W + (size_t)(_k + q) * 6144); } while (0)
#define MODS_ACC(ax, bb, w_, k_) { const f32x4 av = *(const LAS f32x4*)(act + bb * 1024 + (k_)); ax += w_[0] * av[0] + w_[1] * av[1] + w_[2] * av[2] + w_[3] * av[3]; }
#define MODS_STEP(w_, st) do { const int _kk = k0 + 4 * (st); MODS_ACC(a0, 0, w_, _kk) MODS_ACC(a1, 1, w_, _kk) MODS_ACC(a2, 2, w_, _kk) MODS_ACC(a3, 3, w_, _kk) MODS_ACC(a4, 4, w_, _kk) MODS_ACC(a5, 5, w_, _kk) MODS_ACC(a6, 6, w_, _kk) MODS_ACC(a7, 7, w_, _kk) MODS_ACC(a8, 8, w_, _kk) } while (0)
            MODS_LD(wA, 0); MODS_LD(wB, 1); MODS_LD(wC, 2); MODS_LD(wD, 3); __builtin_amdgcn_sched_barrier(0);
#pragma unroll 1
            for (int st = 0; st < 16; st += 4) {
                MODS_STEP(wA, st);     __builtin_amdgcn_sched_barrier(0); MODS_LD(wA, st + 4); __builtin_amdgcn_sched_barrier(0);
                MODS_STEP(wB, st + 1); __builtin_amdgcn_sched_barrier(0); MODS_LD(wB, st + 5); __builtin_amdgcn_sched_barrier(0);
                MODS_STEP(wC, st + 2); __builtin_amdgcn_sched_barrier(0); MODS_LD(wC, st + 6); __builtin_amdgcn_sched_barrier(0);
                MODS_STEP(wD, st + 3); __builtin_amdgcn_sched_barrier(0); MODS_LD(wD, st + 7); __builtin_amdgcn_sched_barrier(0);
            }
#undef MODS_LD
#undef MODS_ACC
#undef MODS_STEP
            LAS f32x4* rw = (LAS f32x4*)(red + F.wave * 9 * 256) + F.lane;
            rw[0] = a0; rw[64] = a1; rw[128] = a2; rw[192] = a3; rw[256] = a4; rw[320] = a5; rw[384] = a6; rw[448] = a7; rw[512] = a8;
            __syncthreads();
            for (int o = F.tid; o < 9 * 256; o += 512) { const int bb = o >> 8, nn = o & 255; float sum = kh == 0 ? adab[layer * 6144 + chunk * 256 + nn] : 0.f;
#pragma unroll
                for (int w = 0; w < 8; ++w) sum += red[(w * 9 + bb) * 256 + nn];
                atomicAdd(F.mods + (size_t)(layer * 9 + bb) * 6144 + chunk * 256 + nn, sum); }
            __syncthreads();
        }
    }
    {
        LAS unsigned* tile = (LAS unsigned*)F.lds;
        constexpr int IT_IN = 8 * 8, IT_OUT = 8 * 4, NIT = 4 * (IT_IN + IT_OUT);
        const float* win = F.in[I_WIN]; const float* wout = F.in[I_WOUT];
        const bool bal = (F.G == 256);
        const int c = (int)blockIdx.x;
        for (int k = 0; k < (bal ? (c >= 192 ? 3 : 1) : (NIT - c + F.G - 1) / F.G); ++k) {
            const int it = bal ? (c >= 192 ? (c - 192) + 64 * k : 192 + c) : c + k * F.G;
            if (it < 4 * IT_IN) { const int l = it / IT_IN, r = it - l * IT_IN; transpose_tile(win + (size_t)l * 1024 * 2048, 1024, 2048, (bf16*)(F.ws + WS_WIN) + (size_t)l * 2048 * 1024, 1, tile, r, F.tid); }
            else { const int q = it - 4 * IT_IN, l = q / IT_OUT, r = q - l * IT_OUT; transpose_tile(wout + (size_t)l * 1024 * 1024, 1024, 1024, (bf16*)(F.ws + WS_WOUT) + (size_t)l * 1024 * 1024, 0, tile, r, F.tid); }
        }
        if (bal && c >= 192) ffn_weight_item(F, c - 192, tile);
    }
    const SsmPtrs Q{F.in[I_LRE], F.in[I_LIM], F.in[I_LSTEP], F.in[I_BRE], F.in[I_BIM], F.in[I_CRE], F.in[I_CIM]};
    const float* ssmd = F.in[I_SSMD]; const float* wglu = F.in[I_WGLU];
    const int gt = blockIdx.x * 512 + F.tid, NGT = F.G * 512;
    for (int i = gt; i < NT; i += NGT) ((int*)(F.ws + WS_IDLIST))[i] = i;
    if (gt < 192) { const int w = gt >> 6, k = gt & 63; unsigned* pz = (unsigned*)(F.ws + WS_BIG + (w == 0 ? BG_VAT + (size_t)NT * 256 * 2 : w == 1 ? BG_VBT + (size_t)NT * 128 * 2 : BG_VDT + (size_t)NT * 128 * 2)); pz[k] = 0u; }
    for (int i = gt; i < 2048 * 32; i += NGT) {
        const int pos = i >> 5, e = i & 31; const int fi = e & 15;
        const float inv = ex2(-(float)fi * (13.287712379549449f / 16.0f));
        const double ang = (double)(e < 16 ? (pos >> 6) : (pos & 63)) * (double)inv;
        double s, c; sincos_d(ang, s, c);
        F.rope[i] = (float)c; F.rope[65536 + i] = (float)s;
    }
    for (int i = gt; i < 4 * 2 * 16 * 64; i += NGT) {
        const int p = i & 63, g = (i >> 6) & 15, d = (i >> 10) & 1, layer = i >> 11;
        const SsmP q = ssm_p(Q, layer, d, g, p);
        f32x2* pw = (f32x2*)(F.ws + WS_SSM + layer * SSM_LAYER + SSM_PW) + (size_t)((d * 16 + g) * 64 + p) * 17;
#pragma unroll 1
        for (int tau = 0; tau <= 16; ++tau) { float are, aim; ssm_apow(q, tau, are, aim); pw[tau] = (f32x2){are, aim}; }
        float fre, fim; ssm_f(q, fre, fim);
        ((f32x2*)(F.ws + WS_SSM + layer * SSM_LAYER + SSM_FF))[(d * 16 + g) * 64 + p] = (f32x2){fre, fim};
    }
    for (int i = gt; i < 4 * 256 * 256; i += NGT) {
        const int ks = i & 255, o = (i >> 8) & 255, layer = i >> 16;
        const int kap = ks >> 5, fq = (ks >> 3) & 3, jj = ks & 7, ch = (2 * kap + (jj >> 2)) * 16 + 4 * fq + (jj & 3);
        ((GAS bf16*)(F.ws + WS_SSM + layer * SSM_LAYER + SSM_WGT))[(((size_t)(o >> 4) * 8 + kap) * 64 + fq * 16 + (o & 15)) * 8 + jj] = (bf16)f2bf(wglu[(size_t)layer * 65536 + ch * 256 + o]);
    }
}

__device__ __forceinline__ void row_stats(const f32x4 (&v)[4], float& mean, float& rstd) {
    float s = 0.f;
#pragma unroll
    for (int j = 0; j < 4; ++j) s += (v[j][0] + v[j][1]) + (v[j][2] + v[j][3]);
    mean = wave_sum(s) * (1.0f / 1024.0f);
    float s2 = 0.f;
#pragma unroll
    for (int j = 0; j < 4; ++j) { const f32x4 d = v[j] - mean; s2 += (d[0] * d[0] + d[1] * d[1]) + (d[2] * d[2] + d[3] * d[3]); }
    rstd = 1.0f / sqrtf(wave_sum(s2) * (1.0f / 1024.0f) + 1e-6f);
}
__device__ __forceinline__ void store_mod_bf16(bf16* dst, const f32x4 (&h)[4], const float* sc, const float* sh, int lane) {
#pragma unroll
    for (int j = 0; j < 4; ++j) {
        const f32x4 s4 = ldgf4(sc + 256 * j + 4 * lane), t4 = ldgf4(sh + 256 * j + 4 * lane);
        const f32x4 a = h[j] * (s4 + 1.0f) + t4;
        stg2(dst + 256 * j + 4 * lane, (u32x2){pk2(a[0], a[1]), pk2(a[2], a[3])});
    }
}

__device__ __forceinline__ void phase_p0b(Frame& F) {
    const float* xin = F.in[I_X]; const float* cin = F.in[I_CTX];
    const float* fg = F.in[I_FG]; const float* fu = F.in[I_FU]; const float* fd = F.in[I_FD];
    {
        const int R = (NT + F.NGW - 1) / F.NGW, i0 = F.gw * R, i1 = (i0 + R < NT) ? i0 + R : NT;
        f32x4 s4[4], t4[4], vn[4]; int cur_bb = -1;
#pragma unroll
        for (int j = 0; j < 4; ++j) { s4[j] = (f32x4){0.f, 0.f, 0.f, 0.f}; t4[j] = s4[j]; vn[j] = s4[j]; }
#define P0B_SRC(m_) ((m_) % TPB < 256 ? cin + ((size_t)((m_) / TPB) * 256 + (m_) % TPB) * 1024 : xin + ((size_t)((m_) / TPB) * 2048 + ((m_) % TPB - 256)) * 1024)
        if (i0 < i1) { const float* src = P0B_SRC(i0);
#pragma unroll
            for (int j = 0; j < 4; ++j) vn[j] = ldgf4(src + 256 * j + 4 * F.lane); }
        for (int m = i0; m < i1; ++m) {
            const int b = m / TPB, t = m - b * TPB, bb = t < 256 ? 8 : b;
            f32x4 v[4];
#pragma unroll
            for (int j = 0; j < 4; ++j) v[j] = vn[j];
            if (m + 1 < i1) { const float* src = P0B_SRC(m + 1);
#pragma unroll
                for (int j = 0; j < 4; ++j) vn[j] = ldgf4(src + 256 * j + 4 * F.lane); }
            if (bb != cur_bb) { cur_bb = bb; const float* sc = modp(F, 0, bb, 1); const float* sh = modp(F, 0, bb, 0);
#pragma unroll
                for (int j = 0; j < 4; ++j) { s4[j] = ldgf4(sc + 256 * j + 4 * F.lane) + 1.0f; t4[j] = ldgf4(sh + 256 * j + 4 * F.lane); } }
#pragma unroll
            for (int j = 0; j < 4; ++j) { const f32x4 a = v[j] * s4[j] + t4[j]; stg2(F.ABF + (size_t)m * 1024 + 256 * j + 4 * F.lane, (u32x2){pk2(a[0], a[1]), pk2(a[2], a[3])}); }
        }
#undef P0B_SRC
    }
    __syncthreads();
    LAS unsigned* tile = (LAS unsigned*)F.lds;
    for (int it = (F.G == 256 ? FFN_EARLY : 0) + (int)blockIdx.x; it < N_F; it += F.G) ffn_weight_item(F, it, tile);
    const int gt = blockIdx.x * 512 + F.tid, NGT = F.G * 512;
    const float* bre = F.in[I_BRE]; const float* bim_ = F.in[I_BIM]; const float* cre = F.in[I_CRE]; const float* cim_ = F.in[I_CIM]; const float* ssmd = F.in[I_SSMD];
    for (int i = gt; i < 4 * 16 * 2 * 64 * 16; i += NGT) {
        const int j = i & 15, p = (i >> 4) & 63, d = (i >> 10) & 1, g = (i >> 11) & 15, layer = i >> 15;
        const unsigned char* tb = F.ws + WS_SSM + layer * SSM_LAYER; const int dgp = (d * 16 + g) * 64 + p;
        const f32x2 a = ((const f32x2*)(tb + SSM_PW))[(size_t)dgp * 17 + (d == 0 ? 15 - j : j)], f = ((const f32x2*)(tb + SSM_FF))[dgp];
        const float xr = a[0] * f[0] - a[1] * f[1], xi = a[0] * f[1] + a[1] * f[0];
        const size_t bi = ((size_t)((layer * 2 + d) * 16 + g) * 64 + p) * 16;
        const float* br = bre + bi; const float* bm = bim_ + bi;
        bf16* wst = (bf16*)(tb + SSM_WST);
        unsigned wr_[8], wi_[8];
#pragma unroll
        for (int h2 = 0; h2 < 8; ++h2) {
            const float b0r = br[2 * h2], b0i = bm[2 * h2], b1r = br[2 * h2 + 1], b1i = bm[2 * h2 + 1];
            wr_[h2] = pk2(xr * b0r - xi * b0i, xr * b1r - xi * b1i); wi_[h2] = pk2(xr * b0i + xi * b0r, xr * b1i + xi * b1r);
        }
        const int n0 = d * 128 + 2 * p;
#pragma unroll
        for (int c = 0; c < 2; ++c) {
            const int n = n0 + c; const size_t blk = (((size_t)g * 16 + (n >> 4)) * 8 + (j >> 1)) * 512 + (n & 15) * 8;
            stg4(wst + blk + (2 * (j & 1)) * 128, c == 0 ? (u32x4){wr_[0], wr_[1], wr_[2], wr_[3]} : (u32x4){wi_[0], wi_[1], wi_[2], wi_[3]});
            stg4(wst + blk + (2 * (j & 1) + 1) * 128, c == 0 ? (u32x4){wr_[4], wr_[5], wr_[6], wr_[7]} : (u32x4){wi_[4], wi_[5], wi_[6], wi_[7]});
        }
    }
    for (int i = gt; i < 4 * 16 * 16 * 16 * 32; i += NGT) {
        const int p4 = i & 15, d = (i >> 4) & 1, ho = (i >> 5) & 15, ii = (i >> 9) & 15, g = (i >> 13) & 15, layer = i >> 17;
        const unsigned char* tb = F.ws + WS_SSM + layer * SSM_LAYER;
        const size_t cb = ((size_t)((layer * 2 + d) * 16 + g) * 16 + ho) * 64 + 4 * p4;
        const f32x4 cr4 = ldgf4(cre + cb), ci4 = ldgf4(cim_ + cb);
        unsigned w[4];
#pragma unroll
        for (int q = 0; q < 4; ++q) {
            const f32x2 a = ((const f32x2*)(tb + SSM_PW))[(size_t)((d * 16 + g) * 64 + 4 * p4 + q) * 17 + (d == 0 ? ii + 1 : 16 - ii)];
            w[q] = pk2(cr4[q] * a[0] - ci4[q] * a[1], -(cr4[q] * a[1] + ci4[q] * a[0]));
        }
        const int k2 = d * 128 + 8 * p4;
        stg4((bf16*)(tb + SSM_G) + ((((size_t)g * 16 + ii) * 8 + (k2 >> 5)) * 64 + ((k2 & 31) >> 3) * 16 + ho) * 8, (u32x4){w[0], w[1], w[2], w[3]});
    }
    for (int i = gt; i < 4 * 16 * 31 * 16 * 8; i += NGT) {
        const int p8 = i & 7, ho = (i >> 3) & 15; int r = i >> 7; const int dl = r % 31; r /= 31; const int g = r & 15, layer = r >> 4;
        const unsigned char* tb = F.ws + WS_SSM + layer * SSM_LAYER;
        float a[16];
#pragma unroll
        for (int h = 0; h < 16; ++h) a[h] = 0.f;
#pragma unroll 1
        for (int d = 0; d < 2; ++d) {
            if ((d == 0 && dl < 15) || (d == 1 && dl > 15)) continue;
            const int tau = d == 0 ? dl - 15 : 15 - dl; const int dg = d * 16 + g;
            const f32x2* pw = (const f32x2*)(tb + SSM_PW) + (size_t)dg * 64 * 17 + tau; const f32x2* ff = (const f32x2*)(tb + SSM_FF) + dg * 64;
            const float* cr = cre + ((size_t)((layer * 2 + d) * 16 + g) * 16 + ho) * 64; const float* cm = cim_ + ((size_t)((layer * 2 + d) * 16 + g) * 16 + ho) * 64;
            const float* br = bre + ((size_t)((layer * 2 + d) * 16 + g) * 64) * 16; const float* bm = bim_ + ((size_t)((layer * 2 + d) * 16 + g) * 64) * 16;
#pragma unroll 2
            for (int pp = 0; pp < 8; ++pp) {
                const int p = p8 * 8 + pp;
                const f32x2 aw = pw[(size_t)p * 17], f = ff[p];
                const float c0 = cr[p], c1 = cm[p];
                const float wr2 = c0 * aw[0] - c1 * aw[1], wi2 = c0 * aw[1] + c1 * aw[0];
                const float xr = wr2 * f[0] - wi2 * f[1], xi = wr2 * f[1] + wi2 * f[0];
#pragma unroll
                for (int q4 = 0; q4 < 4; ++q4) { const f32x4 rr = ldgf4(br + p * 16 + 4 * q4), mm = ldgf4(bm + p * 16 + 4 * q4);
                    a[4 * q4] += xr * rr[0] - xi * mm[0]; a[4 * q4 + 1] += xr * rr[1] - xi * mm[1]; a[4 * q4 + 2] += xr * rr[2] - xi * mm[2]; a[4 * q4 + 3] += xr * rr[3] - xi * mm[3]; }
            }
        }
#pragma unroll
        for (int h = 0; h < 16; ++h) { a[h] += __shfl_xor(a[h], 1); a[h] += __shfl_xor(a[h], 2); a[h] += __shfl_xor(a[h], 4); }
        if (p8 == 0) {
            if (dl == 15) { const float dsk = ssmd[layer * 256 + g * 16 + ho];
#pragma unroll
                for (int h = 0; h < 16; ++h) a[h] += (h == ho) ? dsk : 0.f; }
            bf16* kc = (bf16*)(tb + SSM_KC) + ((size_t)(g * 31 + dl) * 16 + ho) * 16;
            stg4(kc, (u32x4){pk2(a[0], a[1]), pk2(a[2], a[3]), pk2(a[4], a[5]), pk2(a[6], a[7])});
            stg4(kc + 8, (u32x4){pk2(a[8], a[9]), pk2(a[10], a[11]), pk2(a[12], a[13]), pk2(a[14], a[15])});
        }
    }
}

__device__ __forceinline__ void convert_grab(Frame& F, int quota, int until) {
    LAS int* slot = (LAS int*)(F.lds + MISC_OFF + 192);
    LAS unsigned* tile = (LAS unsigned*)F.lds;
    const float* mg = F.in[I_MG]; const float* mu_ = F.in[I_MU]; const float* md = F.in[I_MD];
    for (int n = 0;; ++n) {
        if (F.tid == 0) { int q = -1;
            if (n < quota || (int)__hip_atomic_load(F.ctl + CW_Q, __ATOMIC_RELAXED, __HIP_MEMORY_SCOPE_AGENT) < until) q = (int)__hip_atomic_fetch_add(F.ctl + CW_Q, 1u, __ATOMIC_RELAXED, __HIP_MEMORY_SCOPE_AGENT);
            *slot = q; }
        __syncthreads();
        const int q = __builtin_amdgcn_readfirstlane(*slot);
        __syncthreads();
        if (q < 0 || q >= Q_TOTAL) break;
        const int ie = q / Q_PER, r = q - ie * Q_PER;
        unsigned char* gu = F.ws + WS_WMGU + (size_t)ie * 7168 * 1024;
        if (r < 112) transpose_tile8(mg + (size_t)ie * 1024 * DFE, 1024, DFE, gu, 2, 128.0f, tile, r, F.tid);
        else if (r < 224) transpose_tile8(mu_ + (size_t)ie * 1024 * DFE, 1024, DFE, gu, 3, 128.0f, tile, r - 112, F.tid);
        else transpose_tile8(md + (size_t)ie * DFE * 1024, DFE, 1024, F.ws + WS_WMD + (size_t)ie * 1024 * DFE, 0, 512.0f, tile, r - 224, F.tid);
    }
}
__device__ __forceinline__ int tail_quota(int nwg, int G, int c, int per_round) { const int mx = (nwg + G - 1) / G, mine = c < nwg ? (nwg - c + G - 1) / G : 0; return (mx - mine) * per_round; }

#define LN_ROW(i) (last ? ((i) >> 11) * TPB + 256 + ((i) & 2047) : (i))
template <bool MOE>
__device__ __forceinline__ void phase_ln1(Frame& F, int layer) {
    constexpr bool moe = MOE; const bool last = (layer == DEPTH - 1);
    const bool f8rows = !MOE && ((F8GU_MASK >> (layer >> 1)) & 1) != 0;
    const int nrows = last ? NB * SEQ : NT;
    const float* lg = F.in[I_LN1G] + layer * 1024; const float* lb = F.in[I_LN1B] + layer * 1024;
    LAS int* lcnt = (LAS int*)(F.lds);
    LAS int* rinfo = (LAS int*)(F.lds + 256);
    LAS int* nloc = (LAS int*)(F.lds + 128);
    if (moe) { convert_grab(F, 0, (layer >> 1) == 0 ? Q_TOTAL / 2 : Q_TOTAL); __syncthreads(); if (F.tid < 16) lcnt[F.tid] = 0; if (F.tid == 16) nloc[0] = 0; __syncthreads(); }
    const float* wr_ = F.in[I_MR] + (size_t)(layer >> 1) * 1024 * 8; const float* br_ = F.in[I_MBR] + (layer >> 1) * 8;
    const int R = (nrows + F.NGW - 1) / F.NGW, i0 = F.gw * R, i1 = (i0 + R < nrows) ? i0 + R : nrows;
    f32x4 g4[4], s4[4], t4[4];
#pragma unroll
    for (int j = 0; j < 4; ++j) { g4[j] = ldgf4(lg + 256 * j + 4 * F.lane); s4[j] = g4[j]; t4[j] = g4[j]; }
    f32x4 rw[4][4][2];
#pragma unroll
    for (int j = 0; j < 4; ++j)
#pragma unroll
        for (int q = 0; q < 4; ++q) { rw[j][q][0] = g4[j]; rw[j][q][1] = g4[j]; }
    if (moe) {
#pragma unroll
        for (int j = 0; j < 4; ++j)
#pragma unroll
            for (int q = 0; q < 4; ++q) { const float* w = wr_ + (size_t)(256 * j + 4 * F.lane + q) * 8; rw[j][q][0] = ldgf4(w); rw[j][q][1] = ldgf4(w + 4); } }
    int cur_bb = -1;
#define LN1_LOADROW(buf, ii) do { const int _m = LN_ROW(ii); _Pragma("unroll") for (int j = 0; j < 4; ++j) buf[j] = ldgf4(F.Y + (size_t)_m * 1024 + 256 * j + 4 * F.lane); } while (0)
    auto ln1_row = [&](f32x4 (&v)[4], const int idx) __attribute__((always_inline)) {
        const int m = LN_ROW(idx);
        const int b = m / TPB, t = m - b * TPB, bb = t < 256 ? 8 : b;
        if (bb != cur_bb) { cur_bb = bb; const float* sc = modp(F, layer, bb, 4); const float* sh = modp(F, layer, bb, 3);
#pragma unroll
            for (int j = 0; j < 4; ++j) { const f32x4 s1 = ldgf4(sc + 256 * j + 4 * F.lane) + 1.0f; s4[j] = ldgf4(lg + 256 * j + 4 * F.lane) * s1; t4[j] = ldgf4(lb + 256 * j + 4 * F.lane) * s1 + ldgf4(sh + 256 * j + 4 * F.lane); } }
        float mean, rstd; row_stats(v, mean, rstd);
        if (F.lane == 0) *(GAS f32x2*)((float*)(F.ws + WS_STATS) + 2 * (size_t)m) = (f32x2){mean, rstd};
        f32x4 f[4];
#pragma unroll
        for (int j = 0; j < 4; ++j) {
            f[j] = (v[j] - mean) * rstd * s4[j] + t4[j];
            if (moe || f8rows) *(GAS unsigned*)((unsigned char*)F.ABF + (size_t)m * 1024 + 256 * j + 4 * F.lane) = pk4_fp8(f[j][0] * 16.0f, f[j][1] * 16.0f, f[j][2] * 16.0f, f[j][3] * 16.0f);
            else stg2(F.ABF + (size_t)m * 1024 + 256 * j + 4 * F.lane, (u32x2){pk2(f[j][0], f[j][1]), pk2(f[j][2], f[j][3])});
        }
        if (moe) {
            float lgt[8];
#pragma unroll
            for (int e = 0; e < 8; ++e) lgt[e] = 0.f;
#pragma unroll
            for (int j = 0; j < 4; ++j)
#pragma unroll
                for (int q = 0; q < 4; ++q) {
                    const f32x4 w0 = rw[j][q][0], w1 = rw[j][q][1]; const float x = f[j][q];
                    lgt[0] += x * w0[0]; lgt[1] += x * w0[1]; lgt[2] += x * w0[2]; lgt[3] += x * w0[3]; lgt[4] += x * w1[0]; lgt[5] += x * w1[1]; lgt[6] += x * w1[2]; lgt[7] += x * w1[3];
                }
#pragma unroll
            for (int e = 0; e < 8; ++e) lgt[e] = wave_sum(lgt[e]) + br_[e];
            int e0 = 0; float l0 = lgt[0];
#pragma unroll
            for (int e = 1; e < 8; ++e) if (lgt[e] > l0) { l0 = lgt[e]; e0 = e; }
            int e1 = -1; float l1 = -3.0e38f;
#pragma unroll
            for (int e = 0; e < 8; ++e) if (e != e0 && lgt[e] > l1) { l1 = lgt[e]; e1 = e; }
            const float w1 = 1.0f / (1.0f + ex2((l0 - l1) * LOG2E)), w0 = 1.0f - w1;
            if (F.lane == 0) {
                const int slot = __hip_atomic_fetch_add(nloc, 1, __ATOMIC_RELAXED, __HIP_MEMORY_SCOPE_WORKGROUP); const int p0 = __hip_atomic_fetch_add(&lcnt[e0], 1, __ATOMIC_RELAXED, __HIP_MEMORY_SCOPE_WORKGROUP), p1 = __hip_atomic_fetch_add(&lcnt[e1], 1, __ATOMIC_RELAXED, __HIP_MEMORY_SCOPE_WORKGROUP);
                LAS int* ri = rinfo + slot * 8; ri[0] = m; ri[1] = e0; ri[2] = p0; ri[3] = e1; ri[4] = p1; ri[5] = __builtin_bit_cast(int, w0); ri[6] = __builtin_bit_cast(int, w1);
            }
        }
        };
    f32x4 vA[4], vB[4], vC[4];
#pragma unroll
    for (int j = 0; j < 4; ++j) { vA[j] = (f32x4){0.f, 0.f, 0.f, 0.f}; vB[j] = vA[j]; vC[j] = vA[j]; }
    if (MOE) {
        if (i0 < i1) LN1_LOADROW(vA, i0);
        for (int idx = i0; idx < i1; ++idx) {
#pragma unroll
            for (int j = 0; j < 4; ++j) vB[j] = vA[j];
            if (idx + 1 < i1) LN1_LOADROW(vA, idx + 1);
            ln1_row(vB, idx);
        }
    } else {
        if (i0 < i1) {
            const int il = i1 - 1; int idx = i0;
            LN1_LOADROW(vA, i0); LN1_LOADROW(vB, (i0 + 1 < il ? i0 + 1 : il)); LN1_LOADROW(vC, (i0 + 2 < il ? i0 + 2 : il));
            for (; idx + 3 <= i1; idx += 3) {
                ln1_row(vA, idx);     LN1_LOADROW(vA, (idx + 3 < il ? idx + 3 : il));
                ln1_row(vB, idx + 1); LN1_LOADROW(vB, (idx + 4 < il ? idx + 4 : il));
                ln1_row(vC, idx + 2); LN1_LOADROW(vC, (idx + 5 < il ? idx + 5 : il));
            }
            if (idx < i1) { ln1_row(vA, idx); if (idx + 1 < i1) ln1_row(vB, idx + 1); }
        }
    }
#undef LN1_LOADROW
    if (moe) {
        unsigned* gcnt = F.ctl + CW_CNT + (layer >> 1) * 64;
        __syncthreads();
        if (F.tid < 8) lcnt[8 + F.tid] = (int)__hip_atomic_fetch_add(gcnt + F.tid, (unsigned)lcnt[F.tid], __ATOMIC_RELAXED, __HIP_MEMORY_SCOPE_AGENT);
        __syncthreads();
        const int n = nloc[0]; int* list = (int*)(F.ws + WS_LIST); int* tinfo = (int*)(F.ws + WS_TOKINFO);
        for (int s = F.tid; s < n; s += 512) {
            const LAS int* ri = rinfo + s * 8; const int m = ri[0], e0 = ri[1], e1 = ri[3], q0 = lcnt[8 + e0] + ri[2], q1 = lcnt[8 + e1] + ri[4];
            list[e0 * NT + q0] = m; list[e1 * NT + q1] = m;
            stg4(tinfo + (size_t)m * 8, (u32x4){(unsigned)e0, (unsigned)q0, (unsigned)e1, (unsigned)q1}); tinfo[(size_t)m * 8 + 4] = ri[5]; tinfo[(size_t)m * 8 + 5] = ri[6];
        }
    }
}
__device__ __forceinline__ void phase_ln2(Frame& F, int layer) {
    const bool moe = (layer & 1) != 0, last = (layer == DEPTH - 1);
    const int nrows = last ? NB * SEQ : NT;
    const float* lg = F.in[I_LN2G] + layer * 1024; const float* lb = F.in[I_LN2B] + layer * 1024;
    int pof[8];
    if (moe) { const unsigned* gcnt = F.ctl + CW_CNT + (layer >> 1) * 64; int acc = 0;
#pragma unroll
        for (int e = 0; e < 8; ++e) { pof[e] = acc; acc += (((int)__hip_atomic_load(gcnt + e, __ATOMIC_RELAXED, __HIP_MEMORY_SCOPE_AGENT) + 255) >> 8) << 8; } }
    const bf16* mout = (const bf16*)(F.ws + WS_MOUT); const int* tinfo = (const int*)(F.ws + WS_TOKINFO);
    const float* lg1 = F.in[I_LN1G] + layer * 1024; const float* lb1 = F.in[I_LN1B] + layer * 1024;
    const float* st1 = (const float*)(F.ws + WS_STATS); float* st2 = (float*)(F.ws + WS_STATS) + 2 * NT;
    const int R = (nrows + F.NGW - 1) / F.NGW, i0 = F.gw * R, i1 = (i0 + R < nrows) ? i0 + R : nrows;
    f32x4 g4[4], b4[4], g1[4], b1[4], gt2[4], s4[4], t4[4];
#pragma unroll
    for (int j = 0; j < 4; ++j) { g4[j] = ldgf4(lg + 256 * j + 4 * F.lane); b4[j] = ldgf4(lb + 256 * j + 4 * F.lane); g1[j] = g4[j]; b1[j] = g4[j]; gt2[j] = g4[j]; s4[j] = g4[j]; t4[j] = g4[j]; }
    if (moe) {
#pragma unroll
        for (int j = 0; j < 4; ++j) { g1[j] = ldgf4(lg1 + 256 * j + 4 * F.lane); b1[j] = ldgf4(lb1 + 256 * j + 4 * F.lane); } }
    int cur_bb = -1;
    u32x4 tiN = (u32x4){0u, 0u, 0u, 0u}, tiN2 = tiN; u32x2 twN = (u32x2){0u, 0u}, twN2 = twN; f32x2 s1N = (f32x2){0.f, 0.f};
    u32x2 maN[4], mcN[4];
#pragma unroll
    for (int j = 0; j < 4; ++j) { maN[j] = (u32x2){0u, 0u}; mcN[j] = maN[j]; }
#define LN2_ROWS(ti_, ma_, mc_) do { int _o0 = 0, _o1 = 0; _Pragma("unroll") for (int e = 0; e < 8; ++e) { _o0 = ((int)(ti_).x == e) ? pof[e] : _o0; _o1 = ((int)(ti_).z == e) ? pof[e] : _o1; } \
        const bf16* _r0 = mout + (size_t)(_o0 + (int)(ti_).y) * 1024; const bf16* _r1 = mout + (size_t)(_o1 + (int)(ti_).w) * 1024; \
        _Pragma("unroll") for (int j = 0; j < 4; ++j) { ma_[j] = ldg2(_r0 + 256 * j + 4 * F.lane); mc_[j] = ldg2(_r1 + 256 * j + 4 * F.lane); } } while (0)
    if (moe && i0 < i1) { const int m0 = LN_ROW(i0);
        tiN = *(const GAS u32x4*)(tinfo + (size_t)m0 * 8); twN = *(const GAS u32x2*)(tinfo + (size_t)m0 * 8 + 4); s1N = *(const GAS f32x2*)(st1 + 2 * (size_t)m0);
        { const int m1 = LN_ROW((i0 + 1 < i1 ? i0 + 1 : i1 - 1)); tiN2 = *(const GAS u32x4*)(tinfo + (size_t)m1 * 8); twN2 = *(const GAS u32x2*)(tinfo + (size_t)m1 * 8 + 4); }
        LN2_ROWS(tiN, maN, mcN); }
#define LN2_LOADROW(buf, ii) do { const int _m = LN_ROW(ii); _Pragma("unroll") for (int j = 0; j < 4; ++j) buf[j] = ldgf4(F.Y + (size_t)_m * 1024 + 256 * j + 4 * F.lane); } while (0)
    auto ln2_row = [&](f32x4 (&v)[4], const int idx) __attribute__((always_inline)) {
        const int m = LN_ROW(idx);
        const int b = m / TPB, t = m - b * TPB, bb = t < 256 ? 8 : b;
        if (bb != cur_bb) { cur_bb = bb;
            if (moe) { const float* g2 = modp(F, layer, bb, 5);
#pragma unroll
                for (int j = 0; j < 4; ++j) gt2[j] = ldgf4(g2 + 256 * j + 4 * F.lane); }
            if (!last) { const float* sc = modp(F, layer + 1, bb, 1); const float* sh = modp(F, layer + 1, bb, 0);
#pragma unroll
                for (int j = 0; j < 4; ++j) { s4[j] = ldgf4(sc + 256 * j + 4 * F.lane) + 1.0f; t4[j] = ldgf4(sh + 256 * j + 4 * F.lane); } } }
        if (moe) {
            const u32x2 tw = twN; const unsigned twx = tw.x, twy = tw.y;
            const float w0 = u2f(twx), w1 = u2f(twy);
            const f32x2 s1 = s1N;
            u32x2 ma[4], mc[4];
#pragma unroll
            for (int j = 0; j < 4; ++j) { ma[j] = maN[j]; mc[j] = mcN[j]; }
            tiN = tiN2; twN = twN2;
            { const int m1 = LN_ROW((idx + 1 < i1 ? idx + 1 : i1 - 1)); s1N = *(const GAS f32x2*)(st1 + 2 * (size_t)m1); LN2_ROWS(tiN, maN, mcN); }
            { const int m2 = LN_ROW((idx + 2 < i1 ? idx + 2 : i1 - 1)); tiN2 = *(const GAS u32x4*)(tinfo + (size_t)m2 * 8); twN2 = *(const GAS u32x2*)(tinfo + (size_t)m2 * 8 + 4); }
#pragma unroll
            for (int j = 0; j < 4; ++j) {
                const u32x2 a = ma[j], c = mc[j];
                const f32x4 fa = (f32x4){bf2f(a.x & 0xffffu), bf2f(a.x >> 16), bf2f(a.y & 0xffffu), bf2f(a.y >> 16)}, fc = (f32x4){bf2f(c.x & 0xffffu), bf2f(c.x >> 16), bf2f(c.y & 0xffffu), bf2f(c.y >> 16)};
                const f32x4 h = (v[j] - s1[0]) * s1[1] * g1[j] + b1[j];
                v[j] = h * ALPHA + gt2[j] * (fa * w0 + fc * w1);
                if (!last) stgf4(F.Y + (size_t)m * 1024 + 256 * j + 4 * F.lane, v[j]);
            }
        }
        float mean, rstd; row_stats(v, mean, rstd);
        if (!last && F.lane == 0) *(GAS f32x2*)(st2 + 2 * (size_t)m) = (f32x2){mean, rstd};
#pragma unroll
        for (int j = 0; j < 4; ++j) v[j] = (v[j] - mean) * rstd * g4[j] + b4[j];
        if (last) {
#pragma unroll
            for (int j = 0; j < 4; ++j) stgf4(F.out + ((size_t)b * 2048 + (t - 256)) * 1024 + 256 * j + 4 * F.lane, v[j]);
        } else {
#pragma unroll
            for (int j = 0; j < 4; ++j) { const f32x4 a = v[j] * s4[j] + t4[j]; stg2(F.ABF + (size_t)m * 1024 + 256 * j + 4 * F.lane, (u32x2){pk2(a[0], a[1]), pk2(a[2], a[3])}); }
        }
    };
    f32x4 vA[4], vB[4], vC[4];
#pragma unroll
    for (int j = 0; j < 4; ++j) { vA[j] = (f32x4){0.f, 0.f, 0.f, 0.f}; vB[j] = vA[j]; vC[j] = vA[j]; }
    if (i0 < i1) {
        const int il = i1 - 1; int idx = i0;
        LN2_LOADROW(vA, i0); LN2_LOADROW(vB, (i0 + 1 < il ? i0 + 1 : il)); LN2_LOADROW(vC, (i0 + 2 < il ? i0 + 2 : il));
        for (; idx + 3 <= i1; idx += 3) {
            ln2_row(vA, idx);     LN2_LOADROW(vA, (idx + 3 < il ? idx + 3 : il));
            ln2_row(vB, idx + 1); LN2_LOADROW(vB, (idx + 4 < il ? idx + 4 : il));
            ln2_row(vC, idx + 2); LN2_LOADROW(vC, (idx + 5 < il ? idx + 5 : il));
        }
        if (idx < i1) { ln2_row(vA, idx); if (idx + 1 < i1) ln2_row(vB, idx + 1); }
    }
#undef LN2_LOADROW
}
#undef LN_ROW
#undef LN2_ROWS
constexpr int RPB_MASKED = 2048;
struct AttnP {
    const bf16* q0; const bf16* q1;
    const bf16* K; int kstride;
    const bf16* Vt;
    bf16* o0; bf16* o1;
    int nfull; int has_sink; float sink0, sink1;
    int jg;
    int r, g4; const LAS float* rpb;
};
template <int NG, int MODE>
__device__ __forceinline__ void attn_item(const AttnP& P, int lane) {
    const int fr = lane & 15, fq = lane >> 4;
    bf16x8 qf[NG][2];
#pragma unroll
    for (int ks = 0; ks < 2; ++ks) { qf[0][ks] = ldg8(P.q0 + 32 * ks + 8 * fq); if (NG == 2) qf[NG - 1][ks] = ldg8(P.q1 + 32 * ks + 8 * fq); }
    f32x4 O[NG][4]; float mrun[NG], lrun[NG];
#pragma unroll
    for (int g = 0; g < NG; ++g) { mrun[g] = -1e30f; lrun[g] = 0.f;
#pragma unroll
        for (int dt = 0; dt < 4; ++dt) O[g][dt] = (f32x4){0.f, 0.f, 0.f, 0.f}; }
    int u_lo = 0, nloc = 0, rs = 0, h_lo = 0, nh = 1;
    if (MODE == 1) { int lo = 16 * P.jg - 128; lo = lo < 0 ? 0 : lo; int hi = 16 * P.jg + 143; hi = hi > SEQ - 1 ? SEQ - 1 : hi; u_lo = lo >> 5; nloc = (hi >> 5) - u_lo + 1; }
    if (MODE == 2) { rs = P.r - 4; rs = rs < 0 ? 0 : (rs > 24 ? 24 : rs); h_lo = P.g4 == 3 ? 1 : 0; nh = (P.g4 == 1 || P.g4 == 2) ? 2 : 1; nloc = 8 * nh; }
    const int nfull = P.nfull, ns = nfull + nloc;
    const char* Kb = (const char*)P.K + lane * 16; const char* Vb = (const char*)P.Vt + lane * 16;
    const int qc = 16 * P.g4 + fr; int cs = qc - 8; cs = cs < 0 ? 0 : (cs > 48 ? 48 : cs);
    int dco0[8], dco1[8];
#pragma unroll
    for (int e = 0; e < 8; ++e) { dco0[e] = 0; dco1[e] = 0;
        if (MODE == 2) { { const int kc = 8 * fq + e; int dc = kc - qc; dc = dc < -15 ? -15 : (dc > 15 ? 15 : dc); dco0[e] = (kc >= cs && kc < cs + 16) ? dc : dc + RPB_MASKED; }
                         { const int kc = 32 + 8 * fq + e; int dc = kc - qc; dc = dc < -15 ? -15 : (dc > 15 ? 15 : dc); dco1[e] = (kc >= cs && kc < cs + 16) ? dc : dc + RPB_MASKED; } } }
#define ATT_ST(s) ((s) < nfull ? (s) : (MODE == 1 ? 8 + u_lo + ((s) - nfull) : (nh == 2 ? 8 + 2 * rs + ((s) - nfull) : 8 + 2 * (rs + ((s) - nfull)) + h_lo)))
#define ATT_LOAD(kf, vf, bs, s_) do { const int _st = ATT_ST(s_); const char* _kp = Kb + (size_t)_st * 4096; const char* _vp = Vb + (size_t)_st * 4096; \
        kf[0][0] = ldg8(_kp); kf[0][1] = ldg8(_kp + 1024); kf[1][0] = ldg8(_kp + 2048); kf[1][1] = ldg8(_kp + 3072); \
        vf[0] = ldg8(_vp); vf[1] = ldg8(_vp + 1024); vf[2] = ldg8(_vp + 2048); vf[3] = ldg8(_vp + 3072); \
        if (MODE == 2) { if ((s_) >= nfull) { const int _l = _st - 8, _br = _l >> 1, _hf = _l & 1; const LAS float* _rp = P.rpb + (_br - P.r + 7) * 31 + 15; \
            _Pragma("unroll") for (int e = 0; e < 8; ++e) bs[e] = _rp[_hf ? dco1[e] : dco0[e]]; } } } while (0)
#define ATT_STEP(kf, vf, bs, s_) do { \
        f32x4 sc[NG][2]; \
        _Pragma("unroll") for (int g = 0; g < NG; ++g) _Pragma("unroll") for (int t = 0; t < 2; ++t) { \
            f32x4 a = MODE == 3 ? (f32x4){0.f, 0.f, 0.f, 0.f} : (f32x4){0.f, 0.f, 0.f, 0.f};        \
            a = __builtin_amdgcn_mfma_f32_16x16x32_bf16(kf[t][0], qf[g][0], a, 0, 0, 0); \
            a = __builtin_amdgcn_mfma_f32_16x16x32_bf16(kf[t][1], qf[g][1], a, 0, 0, 0); sc[g][t] = a; } \
        if (MODE == 1 && (s_) >= nfull) { \
            const int _kp0 = 32 * (ATT_ST(s_) - 8); \
            if (!(_kp0 >= 16 * P.jg + 15 - 128 && _kp0 + 31 <= 16 * P.jg + 128)) {           \
                const int qpos = 16 * P.jg + fr; \
                _Pragma("unroll") for (int t = 0; t < 2; ++t) _Pragma("unroll") for (int j = 0; j < 4; ++j) { \
                    const int dd = _kp0 + 8 * fq + 4 * t + j - qpos; const bool ok = dd <= 128 && dd >= -128; \
                    _Pragma("unroll") for (int g = 0; g < NG; ++g) sc[g][t][j] = ok ? sc[g][t][j] : -1e30f; } } } \
        if (MODE == 2 && (s_) >= nfull) {                                                  \
            _Pragma("unroll") for (int t = 0; t < 2; ++t) _Pragma("unroll") for (int j = 0; j < 4; ++j) sc[0][t][j] = sc[0][t][j] + bs[4 * t + j]; } \
        bf16x8 pf[NG]; \
        _Pragma("unroll") for (int g = 0; g < NG; ++g) { \
            float p[8]; float ls = 0.f; \
            if (MODE == 3) {                                                               \
                _Pragma("unroll") for (int t = 0; t < 2; ++t) _Pragma("unroll") for (int j = 0; j < 4; ++j) { p[4 * t + j] = ex2(sc[g][t][j]); ls += p[4 * t + j]; } \
            } else { \
            float mx = fmaxf(fmaxf(fmaxf(sc[g][0][0], sc[g][0][1]), fmaxf(sc[g][0][2], sc[g][0][3])), fmaxf(fmaxf(sc[g][1][0], sc[g][1][1]), fmaxf(sc[g][1][2], sc[g][1][3]))); \
            mx = xmax4(mx); \
            const float mn = fmaxf(mrun[g], mx); \
            if (__builtin_amdgcn_ballot_w64(mn > mrun[g]) != 0ull) { \
                const float al = ex2(mrun[g] - mn); lrun[g] *= al; \
                _Pragma("unroll") for (int dt = 0; dt < 4; ++dt) O[g][dt] = O[g][dt] * al; } \
            mrun[g] = mn; \
            _Pragma("unroll") for (int t = 0; t < 2; ++t) _Pragma("unroll") for (int j = 0; j < 4; ++j) { p[4 * t + j] = ex2(sc[g][t][j] - mn); ls += p[4 * t + j]; } \
            } \
            lrun[g] += ls; \
            const u32x4 pw = (u32x4){cvtpk(p[0], p[1]), cvtpk(p[2], p[3]), cvtpk(p[4], p[5]), cvtpk(p[6], p[7])}; \
            pf[g] = __builtin_bit_cast(bf16x8, pw); } \
          \
        if (NG == 2) asm volatile("s_nop 1" : "+v"(pf[0]), "+v"(pf[NG - 1])); else asm volatile("s_nop 1" : "+v"(pf[0])); \
        _Pragma("unroll") for (int dt = 0; dt < 4; ++dt) _Pragma("unroll") for (int g = 0; g < NG; ++g) O[g][dt] = __builtin_amdgcn_mfma_f32_16x16x32_bf16(vf[dt], pf[g], O[g][dt], 0, 0, 0); } while (0)
    bf16x8 kfA[2][2], vfA[4], kfB[2][2], vfB[4]; float bsA[8], bsB[8];
#pragma unroll
    for (int e = 0; e < 8; ++e) { bsA[e] = 0.f; bsB[e] = 0.f; }
    ATT_LOAD(kfA, vfA, bsA, 0);
    for (int s = 0; s < ns; s += 2) {
        { const int sn = s + 1 < ns ? s + 1 : ns - 1; ATT_LOAD(kfB, vfB, bsB, sn); }
        ATT_STEP(kfA, vfA, bsA, s);
        if (s + 1 < ns) {
            { const int sn = s + 2 < ns ? s + 2 : ns - 1; ATT_LOAD(kfA, vfA, bsA, sn); }
            ATT_STEP(kfB, vfB, bsB, s + 1);
        }
    }
#pragma unroll
    for (int g = 0; g < NG; ++g) {
        float l = xsum4(lrun[g]);
        if (P.has_sink) l += ex2((g == 0 ? P.sink0 : P.sink1) * LOG2E - mrun[g]);
        const float inv = rcpf_(l); bf16* o = g == 0 ? P.o0 : P.o1;
#pragma unroll
        for (int dt = 0; dt < 4; ++dt) { const f32x4 v = O[g][dt] * inv; stg2(o + 16 * dt + 4 * fq, (u32x2){cvtpk(v[0], v[1]), cvtpk(v[2], v[3])}); }
    }
#undef ATT_ST
#undef ATT_LOAD
#undef ATT_STEP
}

__device__ __forceinline__ void attn_b_shared(const AttnP& P, int lane, int wave, LAS unsigned char* lds) {
    const int fq = lane >> 4;
    bf16x8 qf[2][2];
#pragma unroll
    for (int ks = 0; ks < 2; ++ks) { qf[0][ks] = ldg8(P.q0 + 32 * ks + 8 * fq); qf[1][ks] = ldg8(P.q1 + 32 * ks + 8 * fq); }
    f32x4 O[2][4]; float lrun[2];
#pragma unroll
    for (int g = 0; g < 2; ++g) { lrun[g] = 0.f;
#pragma unroll
        for (int dt = 0; dt < 4; ++dt) O[g][dt] = (f32x4){0.f, 0.f, 0.f, 0.f}; }
    const char* src = (const char*)(wave < 4 ? (const void*)P.K : (const void*)P.Vt) + (wave & 3) * 1024 + lane * 16;
    LAS unsigned char* dstw = lds + wave * 1024;
    const LAS unsigned char* rd = lds + lane * 16;
#define ATB_STAGE(st_, slot_) __builtin_amdgcn_global_load_lds((const unsigned*)(src + (size_t)(st_) * 4096), (LAS unsigned*)(dstw + (slot_) * 8192), 16, 0, 0)
    ATB_STAGE(0, 0); ATB_STAGE(1, 1); ATB_STAGE(2, 2);
    f32x4 sc[2][2];
    asm volatile("s_waitcnt vmcnt(2)" ::: "memory");
    __builtin_amdgcn_s_barrier();
    asm volatile("" ::: "memory");
    { bf16x8 kf[2][2]; kf[0][0] = *(const LAS bf16x8*)(rd); kf[0][1] = *(const LAS bf16x8*)(rd + 1024); kf[1][0] = *(const LAS bf16x8*)(rd + 2048); kf[1][1] = *(const LAS bf16x8*)(rd + 3072);
#pragma unroll
      for (int g = 0; g < 2; ++g)
#pragma unroll
        for (int t = 0; t < 2; ++t) { f32x4 a = (f32x4){0.f, 0.f, 0.f, 0.f};
            a = __builtin_amdgcn_mfma_f32_16x16x32_bf16(kf[t][0], qf[g][0], a, 0, 0, 0);
            a = __builtin_amdgcn_mfma_f32_16x16x32_bf16(kf[t][1], qf[g][1], a, 0, 0, 0); sc[g][t] = a; } }
    int slot = 0;
#define ATB_STEP(s_, SC_, SN_) do { \
        asm volatile("s_waitcnt vmcnt(1)" ::: "memory");                       \
        __builtin_amdgcn_s_barrier();                                          \
        asm volatile("" ::: "memory"); \
        { const int sn = (s_) + 3 < 72 ? (s_) + 3 : 71; ATB_STAGE(sn, (slot + 3) & 3); }        \
        const LAS unsigned char* rk = rd + ((slot + 1) & 3) * 8192; const LAS unsigned char* rv = rd + slot * 8192 + 4096; \
        bf16x8 kf[2][2], vf[4]; \
        kf[0][0] = *(const LAS bf16x8*)(rk); kf[0][1] = *(const LAS bf16x8*)(rk + 1024); kf[1][0] = *(const LAS bf16x8*)(rk + 2048); kf[1][1] = *(const LAS bf16x8*)(rk + 3072); \
        vf[0] = *(const LAS bf16x8*)(rv); vf[1] = *(const LAS bf16x8*)(rv + 1024); vf[2] = *(const LAS bf16x8*)(rv + 2048); vf[3] = *(const LAS bf16x8*)(rv + 3072); \
        _Pragma("unroll") for (int g = 0; g < 2; ++g) _Pragma("unroll") for (int t = 0; t < 2; ++t) { f32x4 a = (f32x4){0.f, 0.f, 0.f, 0.f}; \
            a = __builtin_amdgcn_mfma_f32_16x16x32_bf16(kf[t][0], qf[g][0], a, 0, 0, 0); \
            a = __builtin_amdgcn_mfma_f32_16x16x32_bf16(kf[t][1], qf[g][1], a, 0, 0, 0); SN_[g][t] = a; }        \
        __builtin_amdgcn_sched_barrier(0); \
        bf16x8 pf[2]; \
        _Pragma("unroll") for (int g = 0; g < 2; ++g) { float p[8]; float ls = 0.f; \
            _Pragma("unroll") for (int t = 0; t < 2; ++t) _Pragma("unroll") for (int j = 0; j < 4; ++j) { p[4 * t + j] = ex2(SC_[g][t][j]); ls += p[4 * t + j]; } \
            lrun[g] += ls; \
            const u32x4 pw = (u32x4){cvtpk(p[0], p[1]), cvtpk(p[2], p[3]), cvtpk(p[4], p[5]), cvtpk(p[6], p[7])}; \
            pf[g] = __builtin_bit_cast(bf16x8, pw); } \
        asm volatile("s_nop 1" : "+v"(pf[0]), "+v"(pf[1]));                    \
        _Pragma("unroll") for (int dt = 0; dt < 4; ++dt) _Pragma("unroll") for (int g = 0; g < 2; ++g) O[g][dt] = __builtin_amdgcn_mfma_f32_16x16x32_bf16(vf[dt], pf[g], O[g][dt], 0, 0, 0); \
        slot = (slot + 1) & 3; } while (0)
    f32x4 sc2[2][2];
#pragma unroll 1
    for (int s = 0; s < 72; s += 2) { ATB_STEP(s, sc, sc2); ATB_STEP(s + 1, sc2, sc); }
#undef ATB_STEP
#undef ATB_STAGE
    asm volatile("s_waitcnt vmcnt(0)" ::: "memory");
    __builtin_amdgcn_s_barrier();
    asm volatile("" ::: "memory");
#pragma unroll
    for (int g = 0; g < 2; ++g) {
        const float l = xsum4(lrun[g]);
        const float inv = rcpf_(l); bf16* o = g == 0 ? P.o0 : P.o1;
#pragma unroll
        for (int dt = 0; dt < 4; ++dt) { const f32x4 v = O[g][dt] * inv; stg2(o + 16 * dt + 4 * fq, (u32x2){cvtpk(v[0], v[1]), cvtpk(v[2], v[3])}); }
    }
}

__device__ __forceinline__ void ssm_s12_item(Frame& F, int layer, int b, int g, int d) {
    const int fr = F.lane & 15, fq = F.lane >> 4;
    LAS float* S = (LAS float*)F.lds;
    const bf16* U = (const bf16*)(F.big + BG_UG) + (((size_t)g * 72 + b * 9) * 8) * 512 + F.lane * 8;
    const bf16* WsT = (const bf16*)(F.ws + WS_SSM + layer * SSM_LAYER + SSM_WST) + (size_t)g * 16 * 8 * 512 + F.lane * 8;
    bf16x8 bfr[8];
#pragma unroll
    for (int ks = 0; ks < 8; ++ks) bfr[ks] = ldg8(WsT + (size_t)((8 * d + F.wave) * 8 + ks) * 512);
    bf16x8 afA[8], afB[8];
#pragma unroll
    for (int ks = 0; ks < 8; ++ks) afA[ks] = ldg8(U + (size_t)ks * 512);
#define S12_TILE(cur, nxt, mt) do { if ((mt) + 1 < 9) { _Pragma("unroll") for (int ks = 0; ks < 8; ++ks) nxt[ks] = ldg8(U + (size_t)(((mt) + 1) * 8 + ks) * 512); } \
        f32x4 a = (f32x4){0.f, 0.f, 0.f, 0.f}; \
        _Pragma("unroll") for (int ks = 0; ks < 8; ++ks) a = __builtin_amdgcn_mfma_f32_16x16x32_bf16(cur[ks], bfr[ks], a, 0, 0, 0); \
        _Pragma("unroll") for (int j = 0; j < 4; ++j) S[(16 * (mt) + 4 * fq + j) * 128 + F.wave * 16 + fr] = a[j]; } while (0)
    S12_TILE(afA, afB, 0); S12_TILE(afB, afA, 1); S12_TILE(afA, afB, 2); S12_TILE(afB, afA, 3); S12_TILE(afA, afB, 4); S12_TILE(afB, afA, 5); S12_TILE(afA, afB, 6); S12_TILE(afB, afA, 7); S12_TILE(afA, afB, 8);
#undef S12_TILE
    __syncthreads();
    if (F.tid < 64) {
        const int p = F.tid;
        const f32x2 at = ((const f32x2*)(F.ws + WS_SSM + layer * SSM_LAYER + SSM_PW))[(size_t)((d * 16 + g) * 64 + p) * 17 + 16];
        GAS unsigned* hin = (GAS unsigned*)((bf16*)(F.big + BG_HIN) + ((((size_t)(b * 9) * 16 + g) * 8 + 4 * d + (p >> 4)) * 64 + ((p & 15) >> 2) * 16) * 8 + 2 * (p & 3));
        float hr = 0.f, hi = 0.f;
#pragma unroll 1
        for (int k0 = 0; k0 < NCH; k0 += 8) {
            f32x2 sv[8]; int chs[8];
#pragma unroll
            for (int q = 0; q < 8; ++q) { const int k = k0 + q; chs[q] = d == 0 ? k : (k < 16 ? 15 - k : 159 - k);
                sv[q] = *(const LAS f32x2*)(S + chs[q] * 128 + 2 * p); }
#pragma unroll
            for (int q = 0; q < 8; ++q) {
                hin[(size_t)(chs[q] >> 4) * (16 * 8 * 256) + (chs[q] & 15) * 4] = pk2(hr, hi);
                const float nr = at[0] * hr - at[1] * hi + sv[q][0], ni = at[0] * hi + at[1] * hr + sv[q][1];
                hr = nr; hi = ni;
            }
        }
    }
    __syncthreads();
}
__device__ __forceinline__ void ssm_s3_item(Frame& F, int layer, int item) {
    const int fr = F.lane & 15, fq = F.lane >> 4;
    const int ii = item & 15, ct = (item >> 4) % 9, b = item / 144;
    const int ch = 16 * ct + fr;
    const unsigned char* tb = F.ws + WS_SSM + layer * SSM_LAYER;
    const bf16* Gt = (const bf16*)(tb + SSM_G); const bf16* WgT = (const bf16*)(tb + SSM_WGT);
    const char* KcB = (const char*)(tb + SSM_KC); const char* GtB = (const char*)Gt; const char* UB = (const char*)(F.big + BG_UG); const char* HB = (const char*)(F.big + BG_HIN); const char* WB = (const char*)WgT;
    unsigned oK = (unsigned)(((ii + 15) * 16 + fr) * 32 + 16 * (fq & 1) - (fq >> 1) * 512 - 7 * 1024);
    unsigned oG = (unsigned)(ii * 8 * 1024 + F.lane * 16);
    unsigned oU = (unsigned)((size_t)(b * 9 + ct) * 8 * 1024 + F.lane * 16);
    unsigned oH = (unsigned)((size_t)(b * 9 + ct) * 16 * 8 * 1024 + F.lane * 16);
#define S3_LOAD(A_, B_, half) do { if ((half) == 0) { _Pragma("unroll") for (int ks = 0; ks < 8; ++ks) { A_[ks] = ldg8(KcB + oK + (7 - ks) * 1024); B_[ks] = ldg8(UB + oU + 1024 * ks); } } \
        else { _Pragma("unroll") for (int ks = 0; ks < 8; ++ks) { A_[ks] = ldg8(GtB + oG + 1024 * ks); B_[ks] = ldg8(HB + oH + 1024 * ks); } } } while (0)
#define S3_ADV() do { oK += 31 * 512; oG += 131072; oU += NT * 32; oH += 8192; asm volatile("" : "+v"(oK), "+v"(oG), "+v"(oU), "+v"(oH)); } while (0)
    bf16x8 zb[8];
#define S3_LOADH(A_, B_, half, kh) do { if ((half) == 0) { _Pragma("unroll") for (int k4 = 0; k4 < 4; ++k4) { A_[k4] = ldg8(KcB + oK + (7 - ((kh) * 4 + k4)) * 1024); B_[k4] = ldg8(UB + oU + 1024 * ((kh) * 4 + k4)); } } \
        else { _Pragma("unroll") for (int k4 = 0; k4 < 4; ++k4) { A_[k4] = ldg8(GtB + oG + 1024 * ((kh) * 4 + k4)); B_[k4] = ldg8(HB + oH + 1024 * ((kh) * 4 + k4)); } } } while (0)
    bf16x8 ha[4][4], hb[4][4];
    asm volatile("" : "+v"(oK), "+v"(oG), "+v"(oU), "+v"(oH));
    S3_LOADH(ha[0], hb[0], 0, 0); S3_LOADH(ha[1], hb[1], 0, 1); S3_LOADH(ha[2], hb[2], 1, 0);
    float zz[2][4];
    f32x4 a = (f32x4){0.f, 0.f, 0.f, 0.f};
#pragma unroll
    for (int q = 0; q < 64; ++q) {
        if (q + 3 < 64) { S3_LOADH(ha[(q + 3) & 3], hb[(q + 3) & 3], ((q + 3) >> 1) & 1, (q + 3) & 1); if (((q + 3) & 3) == 3) S3_ADV(); }
        __builtin_amdgcn_sched_barrier(0);
        if ((q & 3) == 0) a = (f32x4){0.f, 0.f, 0.f, 0.f};
#pragma unroll
        for (int k4 = 0; k4 < 4; ++k4) a = __builtin_amdgcn_mfma_f32_16x16x32_bf16(ha[q & 3][k4], hb[q & 3][k4], a, 0, 0, 0);
        __builtin_amdgcn_sched_barrier(0);
        if ((q & 3) == 3) {
            const int gg = (q >> 2) & 1, kap = q >> 3;
#pragma unroll
            for (int j = 0; j < 4; ++j) zz[gg][j] = gelu_tanh(a[j]);
            if (gg == 1) {
                const u32x4 w = (u32x4){cvtpk(zz[0][0], zz[0][1]), cvtpk(zz[0][2], zz[0][3]), cvtpk(zz[1][0], zz[1][1]), cvtpk(zz[1][2], zz[1][3])};
                zb[kap] = __builtin_bit_cast(bf16x8, w); asm volatile("s_nop 1" : "+v"(zb[kap]));
            }
        }
    }
#undef S3_LOADH
    bf16x8 a0[8], a1[8];
#undef S3_LOAD
#undef S3_ADV
    const int t = 16 * ch + ii;
    bf16* orow = (bf16*)(F.big + BG_MIX) + ((size_t)b * TPB + t) * 1024 + 512;
    unsigned oW = (unsigned)(F.lane * 16);
    asm volatile("" : "+v"(oW));
#pragma unroll
    for (int kap = 0; kap < 8; ++kap) a0[kap] = ldg8(WB + oW + 1024 * kap);
#pragma unroll
    for (int mu = 0; mu < 16; ++mu) {
        oW += 8192; asm volatile("" : "+v"(oW));
        if (mu < 15) {
            if (mu & 1) {
#pragma unroll
                for (int kap = 0; kap < 8; ++kap) a0[kap] = ldg8(WB + oW + 1024 * kap);
            } else {
#pragma unroll
                for (int kap = 0; kap < 8; ++kap) a1[kap] = ldg8(WB + oW + 1024 * kap);
            }
        }
        __builtin_amdgcn_sched_barrier(0);
        f32x4 a = (f32x4){0.f, 0.f, 0.f, 0.f};
#pragma unroll
        for (int kap = 0; kap < 8; ++kap) a = __builtin_amdgcn_mfma_f32_16x16x32_bf16((mu & 1) ? a1[kap] : a0[kap], zb[kap], a, 0, 0, 0);
        const u32x4 zw = __builtin_bit_cast(u32x4, zb[mu >> 1]);
        const unsigned z01 = (mu & 1) ? zw.z : zw.x, z23 = (mu & 1) ? zw.w : zw.y;
        const float o0 = bf2f(z01 & 0xffffu) * sigmoidf_(a[0]), o1 = bf2f(z01 >> 16) * sigmoidf_(a[1]), o2 = bf2f(z23 & 0xffffu) * sigmoidf_(a[2]), o3 = bf2f(z23 >> 16) * sigmoidf_(a[3]);
        stg2(orow + 16 * mu + 4 * fq, (u32x2){cvtpk(o0, o1), cvtpk(o2, o3)});
        __builtin_amdgcn_sched_barrier(0);
    }
}

__device__ __forceinline__ void phase_m1(Frame& F, int layer, int parts) {
    LAS float* rpbl = (LAS float*)(F.lds + RING_BYTES);
    if (parts & 4) { const float* rp = F.in[I_RPB] + (size_t)layer * 4 * 465; for (int i = F.tid; i < 4 * 465; i += 512) rpbl[i] = rp[i] * LOG2E;
        for (int i = F.tid; i < 4 * 465; i += 512) rpbl[RPB_MASKED + i] = -1e30f; }
    __syncthreads();
    if (parts & 1) for (int it = F.vcu; it < NB * 32; it += F.G) ssm_s12_item(F, layer, it >> 5, (it >> 1) & 15, it & 1);
    if (F.wave >= 4) __builtin_amdgcn_s_setprio(1);
    const int fr = F.lane & 15;
    if (parts & 2) for (int it = F.gw; it < NB * 2 * 128; it += F.NGW) {
        const int jg = it & 127, kvh = (it >> 7) & 1, b = it >> 8;
        const size_t row = (size_t)b * TPB + 256 + 16 * jg + fr;
        AttnP P; P.q0 = (const bf16*)(F.big + BG_QB) + row * 256 + (2 * kvh) * 64; P.q1 = P.q0 + 64;
        P.K = (const bf16*)(F.big + BG_KB) + (size_t)(b * 2 + kvh) * 64 * TPB; P.kstride = 128;
        P.Vt = (const bf16*)(F.big + BG_VBT) + (size_t)(b * 2 + kvh) * 64 * TPB;
        P.o0 = (bf16*)(F.big + BG_MIX) + row * 1024 + 256 + (2 * kvh) * 64; P.o1 = P.o0 + 64;
        P.nfull = 72; P.has_sink = 0; P.sink0 = P.sink1 = 0.f; P.jg = jg; P.r = 0; P.g4 = 0; P.rpb = nullptr;
        if (F.G == 256) attn_b_shared(P, F.lane, F.wave, F.lds); else attn_item<2, 3>(P, F.lane);
    }
    if (parts & 4) for (int k2 = 0, it = (F.G == 256) ? ((F.vcu >> 5) << 9) | ((F.vcu & 31) * 8 + F.wave) : F.gw; it < NB * 4 * 32 * 4 && (F.G != 256 || k2 < 2); ++k2, it += (F.G == 256) ? 256 : F.NGW) {
        const int g4 = it & 3, r = (it >> 2) & 31, h = (it >> 7) & 3, b = it >> 9;
        const size_t row = (size_t)b * TPB + 256 + 64 * r + 16 * g4 + fr;
        AttnP P; P.q0 = (const bf16*)(F.big + BG_QA) + row * 256 + h * 64; P.q1 = P.q0;
        P.K = (const bf16*)(F.big + BG_KA) + (size_t)(b * 4 + h) * 64 * TPB; P.kstride = 256;
        P.Vt = (const bf16*)(F.big + BG_VAT) + (size_t)(b * 4 + h) * 64 * TPB;
        P.o0 = (bf16*)(F.big + BG_MIX) + row * 1024 + h * 64; P.o1 = P.o0;
        P.nfull = 8; P.has_sink = 0; P.sink0 = P.sink1 = 0.f; P.jg = 0; P.r = r; P.g4 = g4; P.rpb = rpbl + h * 465;
        attn_item<1, 2>(P, F.lane);
    }
    __builtin_amdgcn_s_setprio(0);
}
__device__ __forceinline__ void phase_m2(Frame& F, int layer, int M2P) {
    const int fr = F.lane & 15;
    const bool need_ctx = layer < DEPTH - 1;
    if (F.wave >= 4) __builtin_amdgcn_s_setprio(1);
    const float* sink = F.in[I_SINK] + layer * 4; const float* rpb_l = F.in[I_RPB] + (size_t)layer * 4 * 15 * 31;
#define M2_PARTS M2P
    if (M2_PARTS & 1) for (int it = F.gw; it < NB * 2 * 128; it += F.NGW) {
        const int jg = it & 127, kvh = (it >> 7) & 1, b = it >> 8;
        const size_t row = (size_t)b * TPB + 256 + 16 * jg + fr;
        AttnP P; P.q0 = (const bf16*)(F.big + BG_QD) + row * 256 + (2 * kvh) * 64; P.q1 = P.q0 + 64;
        P.K = (const bf16*)(F.big + BG_KD) + (size_t)(b * 2 + kvh) * 64 * TPB; P.kstride = 128;
        P.Vt = (const bf16*)(F.big + BG_VDT) + (size_t)(b * 2 + kvh) * 64 * TPB;
        P.o0 = (bf16*)(F.big + BG_MIX) + row * 1024 + 768 + (2 * kvh) * 64; P.o1 = P.o0 + 64;
        P.nfull = 8; P.has_sink = 1; P.sink0 = sink[2 * kvh]; P.sink1 = sink[2 * kvh + 1]; P.jg = jg; P.r = 0; P.g4 = 0; P.rpb = nullptr;
        attn_item<2, 1>(P, F.lane);
    }
    const bool xl = (F.G == 256);
    const int li = F.wave * 32 + (F.vcu & 31), xb = F.vcu >> 5;
    const int gwp = F.wave * F.G + (int)blockIdx.x;
    if (M2_PARTS & 4) { if (xl) { if (li < 144) ssm_s3_item(F, layer, xb * 144 + li); } else for (int it = gwp; it < NB * 9 * 16; it += F.NGW) ssm_s3_item(F, layer, it); }
    const int cl = xl ? ((li + 256 - 144) & 255) : 0;
    if (need_ctx) {
        if (M2_PARTS & 8) for (int it = xl ? (cl < 64 ? ((cl >> 5) << 8) | (xb << 5) | (cl & 31) : 1 << 30) : (gwp + 896) % F.NGW; it < 2 * NB * 2 * 16; it += F.NGW) {
            const int jq = it & 15, kvh = (it >> 4) & 1, b = (it >> 5) & 7, which = it >> 8;
            const size_t row = (size_t)b * TPB + 16 * jq + fr;
            AttnP P; P.q0 = (const bf16*)(F.big + (which ? BG_QD : BG_QB)) + row * 256 + (2 * kvh) * 64; P.q1 = P.q0 + 64;
            P.K = (const bf16*)(F.big + (which ? BG_KD : BG_KB)) + (size_t)(b * 2 + kvh) * 64 * TPB; P.kstride = 128;
            P.Vt = (const bf16*)(F.big + (which ? BG_VDT : BG_VBT)) + (size_t)(b * 2 + kvh) * 64 * TPB;
            P.o0 = (bf16*)(F.big + BG_MIX) + row * 1024 + (which ? 768 : 256) + (2 * kvh) * 64; P.o1 = P.o0 + 64;
            P.nfull = 8; P.has_sink = which; P.sink0 = sink[2 * kvh]; P.sink1 = sink[2 * kvh + 1]; P.jg = 0; P.r = 0; P.g4 = 0; P.rpb = nullptr;
            attn_item<2, 0>(P, F.lane);
        }
        if (M2_PARTS & 16) for (int it = xl ? (cl >= 64 && cl < 128 ? xb * 64 + (cl - 64) : 1 << 30) : (gwp + 384) % F.NGW; it < NB * 4 * 16; it += F.NGW) {
            const int jq = it & 15, h = (it >> 4) & 3, b = it >> 6;
            const size_t row = (size_t)b * TPB + 16 * jq + fr;
            AttnP P; P.q0 = (const bf16*)(F.big + BG_QA) + row * 256 + h * 64; P.q1 = P.q0;
            P.K = (const bf16*)(F.big + BG_KA) + (size_t)(b * 4 + h) * 64 * TPB; P.kstride = 256;
            P.Vt = (const bf16*)(F.big + BG_VAT) + (size_t)(b * 4 + h) * 64 * TPB;
            P.o0 = (bf16*)(F.big + BG_MIX) + row * 1024 + h * 64; P.o1 = P.o0;
            P.nfull = 8; P.has_sink = 0; P.sink0 = P.sink1 = 0.f; P.jg = 0; P.r = 0; P.g4 = 0; P.rpb = nullptr;
            attn_item<1, 0>(P, F.lane);
        }
    }
    __builtin_amdgcn_s_setprio(0);
}

constexpr int N_PHASES = 2 + 8 * DEPTH;
template <bool ONE>
__global__ void __launch_bounds__(NWAVES * 64, 2) fwd_kernel(Args args) {
    extern __shared__ __attribute__((aligned(16))) unsigned char lds_raw[];
    Frame F;
    F.lds = (LAS unsigned char*)lds_raw;
    F.tid = threadIdx.x; F.lane = F.tid & 63; F.wave = __builtin_amdgcn_readfirstlane(F.tid >> 6);
    F.G = gridDim.x; { const int bx = blockIdx.x; F.vcu = (F.G % 8 == 0) ? (bx % 8) * (F.G / 8) + bx / 8 : bx; }
    F.gw = F.vcu * NWAVES + F.wave; F.NGW = F.G * NWAVES;
    F.in.t = (const LAS unsigned long long*)(F.lds + MISC_OFF + 256); F.out = args.out;
    volatile LAS unsigned* MISC = (volatile LAS unsigned*)(F.lds + MISC_OFF);
    if (F.tid < 64) MISC[F.tid] = 0u;
    if (F.tid == 64) { LAS unsigned long long* tb = (LAS unsigned long long*)(F.lds + MISC_OFF + 256);
#pragma unroll
        for (int i = 0; i < 33; ++i) tb[i] = (unsigned long long)args.in[i]; }
    __syncthreads();
    const int lo = ONE ? 0 : args.ph_lo, hi = ONE ? N_PHASES : args.ph_hi;
    const bool one_launch = ONE;
    XcdBarrier bar; bar.bar = (unsigned*)(args.ws + WS_CTL) + CW_BAR; bar.x = 0; bar.st = MISC + 8;
    if (one_launch) { bar = xcd_barrier_post((unsigned*)(args.ws + WS_CTL) + CW_BAR, MISC + 8);
        if (F.tid == 0) atomicOr((unsigned*)(args.ws + WS_CTL) + CW_XMASK + 64 * (F.vcu >> 5 & 7), 1u << bar.x); }
#ifdef ONLY_MASK
#define IN(k) (((ONLY_MASK >> (((k) < 2) ? (k) : 2 + (((k) - 2) & 7))) & 1) && lo <= (k) && (k) < hi)
#elif defined(ONLY_PHASE)
#define IN(k) ((((k) < 2) ? (k) : 2 + (((k) - 2) & 7)) == ONLY_PHASE && lo <= (k) && (k) < hi)
#else
#define IN(k) (lo <= (k) && (k) < hi)
#endif
#define LAUNDER() do { unsigned _m = ~0u; unsigned char* _w = args.ws; unsigned _lo = MISC_OFF + 256; asm volatile("" : "+s"(_m), "+s"(_w), "+s"(_lo) :: "memory"); \
      \
    int _t = F.wave * 64 + (int)__builtin_amdgcn_mbcnt_hi(_m, __builtin_amdgcn_mbcnt_lo(_m, 0u)); asm volatile("" : "+v"(_t)); F.tid = _t; F.lane = _t & 63; F.ws = _w; \
    F.in.t = (const LAS unsigned long long*)(F.lds + _lo); \
    F.ctl = (unsigned*)(_w + WS_CTL); F.mods = (float*)(_w + WS_MODS); F.rope = (float*)(_w + WS_ROPE); F.H = (float*)(_w + WS_H); F.Y = (float*)(_w + WS_Y); F.ABF = (bf16*)(_w + WS_ABF); F.big = _w + WS_BIG; } while (0)
#define REP(kind) for (int _r = 0; _r < (((REP_MASK) >> (kind)) & 1) + 1; ++_r)
#define REPC(kind, cond) for (int _r = 0; _r < ((((REP_MASK) >> (kind)) & 1) && (cond) ? 2 : 1); ++_r)
#define SEAM(k) do { if (IN((k) + 1)) { XcdBarrier _b = bar; _b.bar = (unsigned*)(args.ws + WS_CTL) + CW_BAR; asm volatile("" : "+s"(_b.bar)); xcd_barrier(_b); } else { VM_WAIT(); __syncthreads(); } } while (0)
#define SEAM_L(k) do { if (one_launch && __builtin_amdgcn_readfirstlane(MISC[11]) != 0u) { if (IN((k) + 1)) { unsigned* _c = (unsigned*)(args.ws + WS_CTL); asm volatile("" : "+s"(_c)); \
        group_barrier(_c + CW_BAR, _c + CW_LBAR + 64 * (F.vcu >> 5 & 7), MISC + 10); } } else SEAM(k); } while (0)
    if (IN(0)) REP(0) { LAUNDER(); phase_p0a(F); SEAM(0);
        if (one_launch) {
            if (F.tid == 0) { const unsigned* xm = (const unsigned*)(args.ws + WS_CTL) + CW_XMASK; bool ok = (gridDim.x == 256);
                for (int g = 0; g < 8; ++g) { const unsigned m = __hip_atomic_load(xm + 64 * g, __ATOMIC_RELAXED, __HIP_MEMORY_SCOPE_AGENT); ok = ok && m != 0u && (m & (m - 1u)) == 0u; }
                MISC[11] = ok ? 1u : 0u; }
            __syncthreads(); } }
    if (IN(1)) REP(1) { LAUNDER(); phase_p0b(F); SEAM(1); }
#pragma unroll 1
    for (int layer = 0; layer < DEPTH; ++layer) {
        const int pb = 2 + 8 * layer;
        const bool moe = (layer & 1) != 0, last = (layer == DEPTH - 1);
        if (IN(pb + 0)) REP(2) { LAUNDER();
            pg8::Sched S; S.init(72, 8, F.G, (int)blockIdx.x, 0);
            EpiInProj E{F.big, F.in[I_GQ] + layer * 64, F.in[I_GK] + layer * 64, F.rope};
            pg8::gemm_phase<EpiInProj, false, false>(F.tid, F.lds, F.ABF, (const bf16*)(F.ws + WS_WIN) + (size_t)layer * 2048 * 1024, 2048, 0, S, E);
            convert_grab(F, tail_quota(S.nwg, F.G, (int)blockIdx.x, 1), 0);
            SEAM_L(pb + 0);
        }
        if (IN(pb + 1)) REP(3) { LAUNDER(); phase_m1(F, layer, _r == 0 ? 7 : PROBE_PARTS); SEAM_L(pb + 1); }
        if (IN(pb + 2)) REP(4) { LAUNDER(); phase_m2(F, layer, _r == 0 ? 31 : PROBE_PARTS); SEAM_L(pb + 2); }
        if (IN(pb + 3)) REPC(5, layer == 0) { LAUNDER();
            pg8::Sched S; S.init(last ? 64 : 72, 4, F.G, (int)blockIdx.x, last ? 1 : 0);
            EpiResid E{layer > 0 ? F.H : F.in[I_X], F.Y, F.mods + (size_t)layer * 9 * 6144, 2, layer > 0 ? 1 : 0, layer > 0 ? F.in[I_LN2G] + (layer - 1) * 1024 : F.in[I_CTX], F.in[I_LN2B] + (layer > 0 ? layer - 1 : 0) * 1024, (const float*)(F.ws + WS_STATS) + 2 * NT, 1.0f};
            pg8::gemm_phase<EpiResid, false, false>(F.tid, F.lds, (const bf16*)(F.big + BG_MIX), (const bf16*)(F.ws + WS_WOUT) + (size_t)layer * 1024 * 1024, 2048, 0, S, E);
            convert_grab(F, tail_quota(S.nwg, F.G, (int)blockIdx.x, 2), 0);
            SEAM_L(pb + 3);
        }
        if (IN(pb + 4)) REPC(6, !moe) { LAUNDER(); if (moe) { phase_ln1<true>(F, layer); SEAM(pb + 4); } else { phase_ln1<false>(F, layer); SEAM_L(pb + 4); } }
        const bool gu8 = moe || ((F8GU_MASK >> (layer >> 1)) & 1) != 0;
        if (IN(pb + 5) && !gu8) REP(7) { LAUNDER();
            LAS int* lc = (LAS int*)(F.lds + MISC_OFF + 128);
            if (F.tid < 8) lc[F.tid] = (F.tid == 0 ? NT : 0);
            __syncthreads();
            pg8::Sched S; S.init_cnt(lc, (const int*)(F.ws + WS_IDLIST), 22, F.G, (int)blockIdx.x);
            EpiSwiglu<true> E{(void*)F.H, DFF, 1.0f};
            pg8::gemm_phase<EpiSwiglu<true>, true, false>(F.tid, F.lds, F.ABF, (const bf16*)(F.ws + WS_WFGU) + (size_t)(layer >> 1) * 5632 * 1024, 2048, 0, S, E);
            convert_grab(F, tail_quota(S.nwg, F.G, (int)blockIdx.x, 1), 0);
            SEAM_L(pb + 5);
        }
        if (IN(pb + 5) && gu8) REP(10) { LAUNDER();
            LAS int* lc = (LAS int*)(F.lds + MISC_OFF + 128);
            if (F.tid < 8) lc[F.tid] = moe ? (int)__hip_atomic_load(F.ctl + CW_CNT + (layer >> 1) * 64 + F.tid, __ATOMIC_RELAXED, __HIP_MEMORY_SCOPE_AGENT) : (F.tid == 0 ? NT : 0);
            __syncthreads();
            pg8::Sched S; S.init_cnt(lc, (const int*)(F.ws + (moe ? WS_LIST : WS_IDLIST)), moe ? 28 : 22, F.G, (int)blockIdx.x);
            EpiSwiglu<true> E{moe ? (void*)F.big : (void*)F.H, moe ? DFE : DFF, 1.0f / 2048.0f};
            pg8::gemm_phase<EpiSwiglu<true>, true, true>(F.tid, F.lds, F.ABF, moe ? F.ws + WS_WMGU + (size_t)(layer >> 1) * 8 * 7168 * 1024 : F.ws + WS_WFGU + (size_t)(layer >> 1) * 5632 * 1024 * 2, 1024, moe ? (size_t)7168 * 1024 : (size_t)0, S, E);
            convert_grab(F, tail_quota(S.nwg, F.G, (int)blockIdx.x, 1), 0);
            if (moe) SEAM(pb + 5); else SEAM_L(pb + 5);
        }
        if (IN(pb + 6)) REPC(8, moe) { LAUNDER();
            if (!moe) {
                pg8::Sched S; S.init(72, 4, F.G, (int)blockIdx.x, 0);
                EpiResid E{F.H, F.Y, F.mods + (size_t)layer * 9 * 6144, 5, 1, F.in[I_LN1G] + layer * 1024, F.in[I_LN1B] + layer * 1024, (const float*)(F.ws + WS_STATS), 1.0f / 4096.0f};
                pg8::gemm_phase<EpiResid, false, true>(F.tid, F.lds, F.H, F.ws + WS_WFD + (size_t)(layer >> 1) * 1024 * DFF, DFF, 0, S, E);
                convert_grab(F, tail_quota(S.nwg, F.G, (int)blockIdx.x, 4), 0);
                SEAM_L(pb + 6);
            } else {
                LAS int* lc = (LAS int*)(F.lds + MISC_OFF + 128);
                if (F.tid < 8) lc[F.tid] = (int)__hip_atomic_load(F.ctl + CW_CNT + (layer >> 1) * 64 + F.tid, __ATOMIC_RELAXED, __HIP_MEMORY_SCOPE_AGENT);
                __syncthreads();
                pg8::Sched S; S.init_cnt(lc, (const int*)(F.ws + WS_LIST), 4, F.G, (int)blockIdx.x);
                EpiBf16Out E{(bf16*)(F.ws + WS_MOUT), 1.0f / 4096.0f};
                pg8::gemm_phase<EpiBf16Out, false, true>(F.tid, F.lds, F.big, F.ws + WS_WMD + (size_t)(layer >> 1) * 8 * 1024 * DFE, DFE, (size_t)1024 * DFE, S, E);
                convert_grab(F, tail_quota(S.nwg, F.G, (int)blockIdx.x, 3), 0);
                SEAM(pb + 6);
            }
        }
        if (IN(pb + 7)) REPC(9, !moe) { LAUNDER(); phase_ln2(F, layer); if (!last) SEAM_L(pb + 7); }
    }
#undef IN
#undef SEAM
#undef SEAM_L
#undef LAUNDER
#undef REP
#undef REPC
}

extern "C" void kernel_launch(void* const* d_in, const int* in_sizes, int n_in, void* d_out, int out_size, void* d_ws, size_t ws_size, hipStream_t stream) {
    static int grid = 0;
    if (grid == 0) {
        if (n_in != 33 || out_size != NB * SEQ * D || ws_size < WS_END) { fprintf(stderr, "kernel_launch: unexpected problem (n_in %d, out %d, ws %zu < %zu)\n", n_in, out_size, ws_size, (size_t)WS_END); grid = -1; return; }
        int dev = 0, cus = 0, per_cu = 0;
        if (hipGetDevice(&dev) != hipSuccess || hipDeviceGetAttribute(&cus, hipDeviceAttributeMultiprocessorCount, dev) != hipSuccess) { grid = -1; return; }
        if (hipFuncSetAttribute((const void*)fwd_kernel<!MK_MULTI>, hipFuncAttributeMaxDynamicSharedMemorySize, LDS_BYTES) != hipSuccess) { fprintf(stderr, "kernel_launch: hipFuncSetAttribute failed\n"); grid = -1; return; }
        if (hipOccupancyMaxActiveBlocksPerMultiprocessor(&per_cu, (const void*)fwd_kernel<!MK_MULTI>, NWAVES * 64, LDS_BYTES) != hipSuccess || per_cu < 1) { fprintf(stderr, "kernel_launch: occupancy query says %d\n", per_cu); }
        (void)hipGetLastError();
        grid = cus;
    }
    if (grid < 0) return;
    if (hipMemsetAsync((char*)d_ws + WS_CTL, 0, CTL_BYTES, stream) != hipSuccess) return;
    Args a{};
    for (int i = 0; i < 33; ++i) a.in[i] = (const float*)d_in[i];
    a.out = (float*)d_out; a.ws = (unsigned char*)d_ws;
#if MK_MULTI
    for (int p = 0; p < N_PHASES; ++p) { a.ph_lo = p; a.ph_hi = p + 1; hipLaunchKernelGGL(fwd_kernel<!MK_MULTI>, dim3(grid), dim3(NWAVES * 64), LDS_BYTES, stream, a); }
#else
    a.ph_lo = 0; a.ph_hi = N_PHASES;
    hipLaunchKernelGGL(fwd_kernel<!MK_MULTI>, dim3(grid), dim3(NWAVES * 64), LDS_BYTES, stream, a);
#endif
}
```
